# Optimizing an MI355X kernel written in HIP

```python
import math
import jax, jax.numpy as jnp
from jax import lax
import numpy as np

D_MODEL = 1024
BATCH = 4
SEQ = 4096
DEPTH = 2
DEC_BATCH = 128
DEC_SEQ = 1
PAST_LEN = 8192
PAGE_SIZE = 128

N_AB_LAYERS = (DEPTH + 1) // 2
N_C_LAYERS = DEPTH // 2
A_HEADS = 8
A_KV_HEADS = 2
A_HEAD_DIM = 64
A_GROUP = A_HEADS // A_KV_HEADS
WINDOW = 128
ATTN_SCALE = A_HEAD_DIM ** -0.5
NUM_BUCKETS = 32
MAX_DISTANCE = 128
A_Q = A_HEADS * A_HEAD_DIM
A_KV = A_KV_HEADS * A_HEAD_DIM
B_GROUPS = 8
B_GROUP_DIM = 64
B_WIDTH = B_GROUPS * B_GROUP_DIM
B_CHUNK = 128
AB_IN = A_Q + 2 * A_KV + 2 * B_WIDTH
AB_MIX = A_Q + B_WIDTH
C_HEADS = 8
C_KEY_DIM = 128
C_VAL_DIM = D_MODEL // C_HEADS
C_F = C_HEADS * C_KEY_DIM
C_V = C_HEADS * C_VAL_DIM
C_IN = 2 * C_F + 2 * C_V
C_CHUNK = 32
D_FF = ((8 * D_MODEL + 767) // 768) * 256
EPS = 1e-6

kernel_name = 'hybrid_swa_gmlp_hgrn2_step'


def _rms(x, g):
    xf = x.astype(jnp.float32)
    y = xf * lax.rsqrt(jnp.mean(xf * xf, axis=-1, keepdims=True) + EPS)
    return (y * g.astype(jnp.float32)).astype(x.dtype)


def _layernorm(x, g, b):
    xf = x.astype(jnp.float32)
    xc = xf - jnp.mean(xf, axis=-1, keepdims=True)
    y = xc * lax.rsqrt(jnp.mean(xc * xc, axis=-1, keepdims=True) + EPS)
    return (y * g.astype(jnp.float32) + b.astype(jnp.float32)).astype(x.dtype)


def _t5_bucket(dist):
    max_exact = NUM_BUCKETS // 2
    d = jnp.maximum(dist, 0)
    dl = jnp.maximum(d, 1).astype(jnp.float32)
    large = max_exact + (jnp.log(dl / max_exact) / math.log(MAX_DISTANCE / max_exact)
                         * (NUM_BUCKETS - max_exact)).astype(jnp.int32)
    large = jnp.minimum(large, NUM_BUCKETS - 1)
    return jnp.where(d < max_exact, d, large)


def _band_bias(dist, ok, rel_bias):
    ok = ok & (dist >= 0) & (dist < WINDOW)
    tab = rel_bias.astype(jnp.float32)[_t5_bucket(dist)]
    tab = jnp.moveaxis(tab, -1, -3)
    b = jnp.where(ok[..., None, :, :], tab, -jnp.inf)
    return b.reshape(b.shape[:-3] + (A_KV_HEADS, A_GROUP) + b.shape[-2:])


def _sink_attend(q, k, v, bias, sink):
    s = jnp.einsum('...qhgd,...khd->...hgqk', q, k, preferred_element_type=jnp.float32) * ATTN_SCALE + bias
    sk = jnp.broadcast_to(sink.astype(jnp.float32).reshape(A_KV_HEADS, A_GROUP, 1, 1), s.shape[:-1] + (1,))
    p = jax.nn.softmax(jnp.concatenate([s, sk], axis=-1), axis=-1)[..., :-1]
    return jnp.einsum('...hgqk,...khd->...qhgd', p.astype(v.dtype), v)


def _ab_project(h, w_in, q_norm, k_norm):
    bn, L = h.shape[:2]
    z = h @ w_in
    q, k, v, zu, zv = jnp.split(z, [A_Q, A_Q + A_KV, A_Q + 2 * A_KV, A_Q + 2 * A_KV + B_WIDTH], axis=-1)
    q = _rms(q.reshape(bn, L, A_HEADS, A_HEAD_DIM), q_norm)
    k = _rms(k.reshape(bn, L, A_KV_HEADS, A_HEAD_DIM), k_norm)
    v = v.reshape(bn, L, A_KV_HEADS, A_HEAD_DIM)
    return q, k, v, zu, zv


def _swa_prompt(q, k, v, rel_bias, sink):
    bn, L = q.shape[:2]
    nb = L // WINDOW
    qb = q.reshape(bn, nb, WINDOW, A_KV_HEADS, A_GROUP, A_HEAD_DIM)

    def band(x):
        xp = jnp.pad(x, ((0, 0), (WINDOW, 0), (0, 0), (0, 0))).reshape(bn, nb + 1, WINDOW, A_KV_HEADS, A_HEAD_DIM)
        return jnp.concatenate([xp[:, :-1], xp[:, 1:]], axis=2)

    qi = jnp.arange(WINDOW)
    kj = jnp.arange(2 * WINDOW)
    dist = qi[:, None] + WINDOW - kj[None, :]
    kpos = jnp.arange(nb)[:, None] * WINDOW - WINDOW + kj[None, :]
    bias = _band_bias(dist, (kpos >= 0)[:, None, :], rel_bias)
    o = _sink_attend(qb, band(k), band(v), bias, sink)
    return o.reshape(bn, L, A_Q)


def _swa_step(q, k_new, v_new, cache_k, cache_v, rel_bias, sink):
    bn, L = q.shape[:2]
    wb = cache_k.shape[1]
    k_all = jnp.concatenate([cache_k.astype(k_new.dtype), k_new], axis=1)
    v_all = jnp.concatenate([cache_v.astype(v_new.dtype), v_new], axis=1)
    qpos = PAST_LEN + jnp.arange(L)
    kpos = PAST_LEN - wb + jnp.arange(wb + L)
    bias = _band_bias(qpos[:, None] - kpos[None, :], (kpos >= 0)[None, :], rel_bias)
    o = _sink_attend(q.reshape(bn, L, A_KV_HEADS, A_GROUP, A_HEAD_DIM), k_all, v_all, bias, sink)
    return o.reshape(bn, L, A_Q), k_all[:, L:], v_all[:, L:]


def _chunk_gmlp(zu, zv, ln_g, ln_b, w_s, b_s):
    bn, L = zu.shape[:2]
    u = jax.nn.gelu(zu, approximate=False)
    v = _layernorm(jax.nn.gelu(zv, approximate=False), ln_g, ln_b)
    nc = -(-L // B_CHUNK)
    pad = nc * B_CHUNK - L
    vp = jnp.pad(v, ((0, 0), (0, pad), (0, 0))).reshape(bn, nc, B_CHUNK, B_GROUPS, B_GROUP_DIM)
    w = jnp.where(jnp.tril(jnp.ones((B_CHUNK, B_CHUNK), bool)), w_s, 0.0).astype(v.dtype)
    s = jnp.einsum('gts,bcsgd->bctgd', w, vp) + b_s.T.astype(v.dtype)[:, :, None]
    s = s.reshape(bn, nc * B_CHUNK, B_WIDTH)[:, :L]
    open_start = ((L - 1) // B_CHUNK) * B_CHUNK
    return u * s, v[:, open_start:]


def _hgrn2_scan(q, fl, i, lb, s0):
    bn, L = q.shape[:2]
    f = lb + (1.0 - lb) * jax.nn.sigmoid(fl.astype(jnp.float32))
    g = jnp.log(f)
    kk = 1.0 - f
    c = min(C_CHUNK, L)
    nc = -(-L // c)
    pad = nc * c - L

    def chunks(x):
        x = jnp.pad(x.astype(jnp.float32), ((0, 0), (0, pad), (0, 0), (0, 0)))
        return x.reshape(bn, nc, c, x.shape[2], x.shape[3]).transpose(1, 0, 3, 2, 4)

    mask = jnp.tril(jnp.ones((c, c), bool))[:, :, None]

    def step(S, xs):
        qc, kc, vc, gc = xs
        b = jnp.cumsum(gc, axis=2)
        o = jnp.einsum('bhtd,bhde->bhte', qc * jnp.exp(b), S)
        decay = jnp.exp(jnp.where(mask, b[:, :, :, None, :] - b[:, :, None, :, :], -jnp.inf))
        att = jnp.einsum('bhtd,bhsd,bhtsd->bhts', qc, kc, decay)
        o = o + jnp.einsum('bhts,bhse->bhte', att, vc)
        b_last = b[:, :, -1:, :]
        S = jnp.exp(b_last[:, :, 0, :])[..., None] * S + jnp.einsum('bhsd,bhse->bhde', kc * jnp.exp(b_last - b), vc)
        return S, o

    S, o = lax.scan(step, s0.astype(jnp.float32), (chunks(q), chunks(kk), chunks(i), chunks(g)))
    o = o.transpose(1, 0, 3, 2, 4).reshape(bn, nc * c, q.shape[2], i.shape[3])[:, :L]
    return o, S


def _hgrn_mixer(h, w_in, lb_l, out_norm, w_out, s0):
    bn, L = h.shape[:2]
    z = h @ w_in
    q, fl, i, gt = jnp.split(z, [C_F, 2 * C_F, 2 * C_F + C_V], axis=-1)
    o, S = _hgrn2_scan(q.reshape(bn, L, C_HEADS, C_KEY_DIM), fl.reshape(bn, L, C_HEADS, C_KEY_DIM),
                       i.reshape(bn, L, C_HEADS, C_VAL_DIM), lb_l.reshape(C_HEADS, C_KEY_DIM), s0)
    o = _rms(o.astype(h.dtype), out_norm) * jax.nn.sigmoid(gt).reshape(bn, L, C_HEADS, C_VAL_DIM)
    return o.reshape(bn, L, C_V) @ w_out, S


def _ffn(x, g, w_gate, w_up, w_down):
    h = _rms(x, g)
    return x + (jax.nn.silu(h @ w_gate) * (h @ w_up)) @ w_down


def setup_inputs(seed: int = 0) -> dict:
    key = jax.random.key(seed)
    ks = jax.random.split(key, 24)

    def nrm(k, shape, scale):
        return scale * jax.random.normal(k, shape, jnp.float32)

    wbuf = min(WINDOW, PAST_LEN)
    return {
        'x_prompt': nrm(ks[0], (BATCH, SEQ, D_MODEL), 1.0),
        'x_sample': nrm(ks[1], (DEC_BATCH, DEC_SEQ, D_MODEL), 1.0),
        'cache_k': nrm(ks[2], (N_AB_LAYERS, DEC_BATCH, wbuf, A_KV_HEADS, A_HEAD_DIM), 1.0),
        'cache_v': nrm(ks[3], (N_AB_LAYERS, DEC_BATCH, wbuf, A_KV_HEADS, A_HEAD_DIM), 1.0),
        'state_hgrn': nrm(ks[4], (N_C_LAYERS, DEC_BATCH, C_HEADS, C_KEY_DIM, C_VAL_DIM), 0.5),
        'norm_mix': 1.0 + nrm(ks[5], (DEPTH, D_MODEL), 0.05),
        'norm_ffn': 1.0 + nrm(ks[6], (DEPTH, D_MODEL), 0.05),
        'w_in_ab': nrm(ks[7], (N_AB_LAYERS, D_MODEL, AB_IN), D_MODEL ** -0.5),
        'w_out_ab': nrm(ks[8], (N_AB_LAYERS, AB_MIX, D_MODEL), AB_MIX ** -0.5),
        'q_norm': 1.0 + nrm(ks[9], (N_AB_LAYERS, A_HEAD_DIM), 0.05),
        'k_norm': 1.0 + nrm(ks[10], (N_AB_LAYERS, A_HEAD_DIM), 0.05),
        'attn_sink': nrm(ks[11], (N_AB_LAYERS, A_HEADS), 0.5),
        'rel_bias': nrm(ks[12], (NUM_BUCKETS, A_HEADS), 0.5),
        'gmlp_ln_g': 1.0 + nrm(ks[13], (N_AB_LAYERS, B_WIDTH), 0.05),
        'gmlp_ln_b': nrm(ks[14], (N_AB_LAYERS, B_WIDTH), 0.02),
        'gmlp_w_s': nrm(ks[15], (N_AB_LAYERS, B_GROUPS, B_CHUNK, B_CHUNK), B_CHUNK ** -0.5),
        'gmlp_b_s': 1.0 + nrm(ks[16], (N_AB_LAYERS, B_GROUPS, B_CHUNK), 0.1),
        'w_in_c': nrm(ks[17], (N_C_LAYERS, D_MODEL, C_IN), D_MODEL ** -0.5),
        'c_lower_bounds': nrm(ks[18], (DEPTH, C_F), 0.1),
        'c_out_norm': 1.0 + nrm(ks[19], (N_C_LAYERS, C_VAL_DIM), 0.05),
        'w_out_c': nrm(ks[20], (N_C_LAYERS, C_V, D_MODEL), C_V ** -0.5),
        'w_gate': nrm(ks[21], (DEPTH, D_MODEL, D_FF), D_MODEL ** -0.5),
        'w_up': nrm(ks[22], (DEPTH, D_MODEL, D_FF), D_MODEL ** -0.5),
        'w_down': nrm(ks[23], (DEPTH, D_FF, D_MODEL), D_FF ** -0.5),
    }


def reference(x_prompt, x_sample, cache_k, cache_v, state_hgrn,
              norm_mix, norm_ffn, w_in_ab, w_out_ab, q_norm, k_norm, attn_sink, rel_bias,
              gmlp_ln_g, gmlp_ln_b, gmlp_w_s, gmlp_b_s,
              w_in_c, c_lower_bounds, c_out_norm, w_out_c,
              w_gate, w_up, w_down):
    lb = jax.nn.softmax(c_lower_bounds.astype(jnp.float32), axis=0)
    lb = jnp.cumsum(lb, axis=0) - lb[0:1]

    xp, xs = x_prompt, x_sample
    kp_l, vp_l, ks_l, vs_l = [], [], [], []
    gvp_l, gvs_l, sp_l, ss_l = [], [], [], []
    for l in range(DEPTH):
        j = l // 2
        hp = _rms(xp, norm_mix[l])
        hs = _rms(xs, norm_mix[l])
        if l % 2 == 0:
            q, k, v, zu, zv = _ab_project(hp, w_in_ab[j], q_norm[j], k_norm[j])
            a = _swa_prompt(q, k, v, rel_bias, attn_sink[j])
            b, gv = _chunk_gmlp(zu, zv, gmlp_ln_g[j], gmlp_ln_b[j], gmlp_w_s[j], gmlp_b_s[j])
            xp = xp + jnp.concatenate([a, b], axis=-1) @ w_out_ab[j]
            nwin = min(WINDOW, k.shape[1])
            kp_l.append(k[:, -nwin:])
            vp_l.append(v[:, -nwin:])
            gvp_l.append(gv)
            q, k, v, zu, zv = _ab_project(hs, w_in_ab[j], q_norm[j], k_norm[j])
            a, kw, vw = _swa_step(q, k, v, cache_k[j], cache_v[j], rel_bias, attn_sink[j])
            b, gv = _chunk_gmlp(zu, zv, gmlp_ln_g[j], gmlp_ln_b[j], gmlp_w_s[j], gmlp_b_s[j])
            xs = xs + jnp.concatenate([a, b], axis=-1) @ w_out_ab[j]
            ks_l.append(kw)
            vs_l.append(vw)
            gvs_l.append(gv)
        else:
            s0 = jnp.zeros((xp.shape[0], C_HEADS, C_KEY_DIM, C_VAL_DIM), jnp.float32)
            o, s = _hgrn_mixer(hp, w_in_c[j], lb[l], c_out_norm[j], w_out_c[j], s0)
            xp = xp + o
            sp_l.append(s.astype(xp.dtype))
            o, s = _hgrn_mixer(hs, w_in_c[j], lb[l], c_out_norm[j], w_out_c[j], state_hgrn[j])
            xs = xs + o
            ss_l.append(s.astype(state_hgrn.dtype))
        xp = _ffn(xp, norm_ffn[l], w_gate[l], w_up[l], w_down[l])
        xs = _ffn(xs, norm_ffn[l], w_gate[l], w_up[l], w_down[l])

    new_k_prompt = jnp.stack(kp_l)
    new_v_prompt = jnp.stack(vp_l)
    new_k_sample = jnp.stack(ks_l)
    new_v_sample = jnp.stack(vs_l)
    gmlp_v_prompt = jnp.stack(gvp_l)
    gmlp_v_sample = jnp.stack(gvs_l)
    state_hgrn_prompt = jnp.stack(sp_l)
    state_hgrn_sample = jnp.stack(ss_l)
    return (xp, xs, new_k_prompt, new_v_prompt, new_k_sample, new_v_sample,
            gmlp_v_prompt, gmlp_v_sample, state_hgrn_prompt, state_hgrn_sample)
```

```cpp
#include <hip/hip_runtime.h>
#include <math.h>
#include <stdint.h>
#include <cstdio>

#define LAS __attribute__((address_space(3)))
typedef unsigned short bf16_t;
typedef short bf16x8 __attribute__((ext_vector_type(8)));
typedef float f32x4 __attribute__((ext_vector_type(4)));
typedef float f32x2 __attribute__((ext_vector_type(2)));
typedef unsigned u32x4 __attribute__((ext_vector_type(4)));
typedef unsigned u32x2 __attribute__((ext_vector_type(2)));

namespace fk {
constexpr int DM = 1024, SEQ = 4096, NBATCH = 4, DEC = 128;
constexpr int MP = NBATCH * SEQ, MTOT = MP + DEC, MPAD = 16640;
constexpr int N_INAB = 1792, FF = 2816, N_GU = 2 * FF, N_INC = 4096;
constexpr float EPS = 1e-6f;
constexpr float LOG2E = 1.4426950408889634f;
#ifndef NSEG_
#define NSEG_ 8
#endif
constexpr int NSEG = NSEG_, SEGLEN = SEQ / NSEG, CH = 32;

constexpr size_t MiB = 1u << 20;
constexpr size_t WS_CTL = 0, CTL_BYTES = MiB, CTL_ZERO_BYTES = 32768;
constexpr size_t SZ_INAB = (size_t)N_INAB * DM * 2, SZ_SQ = (size_t)DM * DM * 2, SZ_GU = (size_t)N_GU * DM * 2, SZ_DN = (size_t)DM * FF * 2, SZ_INC = (size_t)N_INC * DM * 2;
constexpr size_t WS_W_INAB = 1 * MiB, WS_W_OUTAB = WS_W_INAB + SZ_INAB, WS_W_GU0 = WS_W_OUTAB + SZ_SQ, WS_W_DN0 = WS_W_GU0 + SZ_GU;
constexpr size_t WS_W_INC = WS_W_DN0 + SZ_DN, WS_W_OUTC = WS_W_INC + SZ_INC, WS_W_GU1 = WS_W_OUTC + SZ_SQ, WS_W_DN1 = WS_W_GU1 + SZ_GU;
constexpr size_t WS_WTRIL = WS_W_DN1 + SZ_DN;
constexpr size_t WS_SMALL = 50 * MiB;
constexpr size_t WS_SS = WS_SMALL;
constexpr size_t WS_LNS = WS_SS + (size_t)MPAD * 32 * 4;
constexpr size_t WS_BIAS2 = WS_LNS + (size_t)MPAD * 16 * 4;
constexpr size_t WS_LBT = WS_BIAS2 + 8 * 128 * 4;
constexpr size_t WS_ATOT = WS_LBT + 1024 * 4;
constexpr size_t WS_A = 54 * MiB;
constexpr size_t A_BYTES = (size_t)MPAD * DM * 2;
constexpr size_t WS_B = WS_A + A_BYTES;
constexpr size_t WS_END = WS_B + 5 * A_BYTES;
static_assert(WS_WTRIL + 8 * 128 * 128 * 2 <= WS_SMALL && WS_ATOT + 256 * 128 * 4 <= WS_A && WS_END <= 256 * MiB, "ws map");
constexpr size_t WS_SLOC = WS_W_INAB;
static_assert(WS_SLOC + (size_t)256 * 128 * 128 * 4 <= WS_W_INC, "sloc overlay");
constexpr size_t B_Q0 = 0, B_K0 = B_Q0 + (size_t)MPAD * 512 * 2, B_V0 = B_K0 + (size_t)MPAD * 128 * 2, B_U0 = B_V0 + (size_t)MPAD * 128 * 2, B_GV0 = B_U0 + (size_t)MPAD * 512 * 2;
constexpr size_t B_XB = 0, B_HID = A_BYTES;
static_assert(B_GV0 + (size_t)MPAD * 512 * 2 <= 5 * A_BYTES && B_HID + (size_t)MPAD * FF * 2 <= 5 * A_BYTES, "B map");
constexpr int CW_BAR = 4096;

constexpr int RING_BYTES = 131072, MISC_OFF = RING_BYTES + 320, LDS_BYTES = 147456;

typedef __bf16 bf16x2_t __attribute__((ext_vector_type(2)));
__device__ __forceinline__ unsigned cvt_pk_bf16(float lo, float hi) { const f32x2 v = {lo, hi}; const bf16x2_t b = __builtin_convertvector(v, bf16x2_t); return __builtin_bit_cast(unsigned, b); }
__device__ __forceinline__ bf16_t f2bf(float f) { return (bf16_t)(cvt_pk_bf16(f, 0.f) & 0xffffu); }
__device__ __forceinline__ float bf2f(unsigned u) { return __uint_as_float(u << 16); }
__device__ __forceinline__ float bflo(unsigned w) { return __uint_as_float(w << 16); }
__device__ __forceinline__ float bfhi(unsigned w) { return __uint_as_float(w & 0xffff0000u); }
__device__ __forceinline__ unsigned short f2h(float f) { _Float16 h = (_Float16)f; return __builtin_bit_cast(unsigned short, h); }
__device__ __forceinline__ float h2f(unsigned short u) { return (float)__builtin_bit_cast(_Float16, u); }
__device__ __forceinline__ float ex2(float x) { return __builtin_amdgcn_exp2f(x); }
__device__ __forceinline__ float sigm(float x) { return __builtin_amdgcn_rcpf(1.f + ex2(-x * LOG2E)); }
__device__ __forceinline__ float wsum(float v) {
#pragma unroll
    for (int o = 1; o < 64; o <<= 1) v += __shfl_xor(v, o);
    return v;
}
__device__ __forceinline__ float wmax(float v) {
#pragma unroll
    for (int o = 1; o < 64; o <<= 1) v = fmaxf(v, __shfl_xor(v, o));
    return v;
}
__device__ __forceinline__ f32x2 gelu_pk(f32x2 v) {
    const f32x2 av = __builtin_elementwise_abs(v), d = av * 0.2316418882f + 1.0f;
    f32x2 t; t.x = __builtin_amdgcn_rcpf(d.x); t.y = __builtin_amdgcn_rcpf(d.y);
    f32x2 q = t * 0.5307027145f + (-0.7265760135f); q = q * t + 0.7107068705f; q = q * t + (-0.142248368f); q = q * t + 0.127414796f; q = q * t;
    const f32x2 s = (v * v) * (-0.72134752044f);
    f32x2 e; e.x = ex2(s.x); e.y = ex2(s.y);
    const f32x2 m = v * (q * e), r = v - m;
    f32x2 o; o.x = v.x < 0.f ? m.x : r.x; o.y = v.y < 0.f ? m.y : r.y; return o;
}
__device__ __forceinline__ f32x4 gelu4(f32x4 v) { f32x2 a = gelu_pk((f32x2){v[0], v[1]}), b = gelu_pk((f32x2){v[2], v[3]}); return (f32x4){a.x, a.y, b.x, b.y}; }
__device__ __forceinline__ u32x4 pack8(f32x4 a, f32x4 b) { u32x4 w; w.x = cvt_pk_bf16(a[0], a[1]); w.y = cvt_pk_bf16(a[2], a[3]); w.z = cvt_pk_bf16(b[0], b[1]); w.w = cvt_pk_bf16(b[2], b[3]); return w; }
__device__ __forceinline__ u32x2 pack4(f32x4 a) { u32x2 w; w.x = cvt_pk_bf16(a[0], a[1]); w.y = cvt_pk_bf16(a[2], a[3]); return w; }
__device__ __forceinline__ f32x4 mfma16(bf16x8 a, bf16x8 b, f32x4 c) { return __builtin_amdgcn_mfma_f32_16x16x32_bf16(a, b, c, 0, 0, 0); }

__device__ __constant__ int T5B[128] = {0, 1, 2, 3, 4, 5, 6, 7, 8, 9, 10, 11, 12, 13, 14, 15, 16, 16, 16, 17, 17, 18, 18, 18, 19, 19, 19, 20, 20, 20, 20, 21, 21, 21, 21, 22, 22, 22, 22, 22, 23, 23, 23, 23, 23, 23, 24, 24, 24, 24, 24, 24, 25, 25, 25, 25, 25, 25, 25, 26, 26, 26, 26, 26, 26, 26, 26, 27, 27, 27, 27, 27, 27, 27, 27, 27, 27, 28, 28, 28, 28, 28, 28, 28, 28, 28, 28, 29, 29, 29, 29, 29, 29, 29, 29, 29, 29, 29, 29, 30, 30, 30, 30, 30, 30, 30, 30, 30, 30, 30, 30, 30, 30, 31, 31, 31, 31, 31, 31, 31, 31, 31, 31, 31, 31, 31, 31, 31};

#define XB_TMO      128
#define XB_XCNT(j)  (256  + 64 * (j))
#define XB_XSUB(j)  (1280 + 64 * (j))
#define XB_XGEN(j)  (2304 + 64 * (j))
#define XB_TOP      3328
#define XB_TOPGEN   3392
#define XCD_BAR_WORDS 3456
#define XB_SPIN_CAP (1u << 18)
__device__ __forceinline__ unsigned xb_ld(unsigned* p)              { return __hip_atomic_load(p, __ATOMIC_RELAXED, __HIP_MEMORY_SCOPE_AGENT); }
__device__ __forceinline__ unsigned xb_add(unsigned* p, unsigned v) { return __hip_atomic_fetch_add(p, v, __ATOMIC_RELAXED, __HIP_MEMORY_SCOPE_AGENT); }
__device__ __forceinline__ unsigned xb_xcc_id() { return (unsigned)__builtin_amdgcn_s_getreg((3 << 11) | 20) & 0xFu; }
#define XB_SPIN(cond, bar) do { unsigned _sp = 0; while (cond) { __builtin_amdgcn_s_sleep(1); \
    if ((++_sp & 255u) == 0u) { if (xb_ld(&(bar)[XB_TMO])) break; if (_sp > XB_SPIN_CAP) { atomicAdd(&(bar)[XB_TMO], 1u); break; } } } } while (0)
struct XcdBarrier { unsigned* bar; unsigned x; volatile LAS unsigned* st; };
__device__ __forceinline__ XcdBarrier xcd_barrier_post(unsigned* bar, volatile LAS unsigned* st) {
    XcdBarrier b; b.bar = bar; b.x = xb_xcc_id(); b.st = st;
    if (threadIdx.x == 0) (void)xb_add(&bar[XB_XCNT(b.x)], 1u);
    return b;
}
__device__ __forceinline__ void xcd_barrier_complete(unsigned* bar, unsigned x, unsigned& nloc, unsigned& nx) {
    const unsigned G = gridDim.x * gridDim.y * gridDim.z;
    unsigned sum, cnt, mine, sp = 0u;
    for (;;) {
        sum = 0u; cnt = 0u; mine = 0u;
#pragma unroll
        for (unsigned j = 0; j < 16; ++j) { const unsigned c = xb_ld(&bar[XB_XCNT(j)]); sum += c; cnt += (c > 0u) ? 1u : 0u; mine = (j == x) ? c : mine; }
        if (sum == G) break;
        __builtin_amdgcn_s_sleep(1);
        if ((++sp & 255u) == 0u) { if (xb_ld(&bar[XB_TMO])) break; if (sp > XB_SPIN_CAP) { atomicAdd(&bar[XB_TMO], 1u); break; } }
    }
    nloc = mine > 0u ? mine : 1u; nx = cnt > 0u ? cnt : 1u;
}
__device__ __forceinline__ void xcd_barrier(const XcdBarrier& b) {
    asm volatile("s_waitcnt vmcnt(0)" ::: "memory");
    __syncthreads();
    if (threadIdx.x == 0) {
        unsigned* bar = b.bar;
        __builtin_amdgcn_s_waitcnt(0);
        unsigned nloc = b.st[0], nx = b.st[1];
        if (nloc == 0u) { xcd_barrier_complete(bar, b.x, nloc, nx); b.st[0] = nloc; b.st[1] = nx; }
        const unsigned old = xb_add(&bar[XB_XSUB(b.x)], 1u);
        const unsigned gen = old / nloc;
        if (old + 1u == (gen + 1u) * nloc) {
            __builtin_amdgcn_fence(__ATOMIC_RELEASE, "agent");
            asm volatile("s_waitcnt vmcnt(0)" ::: "memory");
            const unsigned og = xb_add(&bar[XB_TOP], 1u);
            const unsigned tg = og / nx;
            if (og + 1u == (tg + 1u) * nx) xb_add(&bar[XB_TOPGEN], 1u);
            else XB_SPIN(xb_ld(&bar[XB_TOPGEN]) == tg, bar);
            __builtin_amdgcn_fence(__ATOMIC_ACQUIRE, "agent");
            xb_add(&bar[XB_XGEN(b.x)], 1u);
            asm volatile("s_waitcnt vmcnt(0)" ::: "memory");
        } else {
            XB_SPIN(xb_ld(&bar[XB_XGEN(b.x)]) == gen, bar);
            __builtin_amdgcn_fence(__ATOMIC_ACQUIRE, "agent");
            asm volatile("s_waitcnt vmcnt(0)" ::: "memory");
        }
    }
    __syncthreads();
}

constexpr int BM = 256, BK = 64, HALF = 128, HTB = HALF * BK * 2, NXCD = 8, WGM = 8;
__host__ __device__ __forceinline__ int lds_byte(int r, int c) { const int st = (r >> 4) * 2 + (c >> 5), rr = r & 15, cc = c & 31, ob = rr * 64 + cc * 2; return st * 1024 + (ob ^ (((ob >> 9) & 1) << 5)); }
__host__ __device__ __forceinline__ void stage_rc(int b, int& R, int& C) { const int st = b / 1024, sb = b % 1024, swz = sb ^ (((sb >> 9) & 1) << 5); R = (st >> 1) * 16 + swz / 64; C = (st & 1) * 32 + (swz % 64) / 2; }
struct Unit { int pm, pn; };
struct Gemm { const bf16_t* A; const bf16_t* Bt; int M, N, K; };
struct StaticOrder {
    int nM, nN, nwg, G, c;
    __device__ void init(int M, int N, int G_, int c_) { nM = M / BM; nN = N / BM; nwg = nM * nN; G = G_; c = c_; }
    __device__ bool next(int i, Unit& u) const {
        const long L = (long)i * G + c; if (L >= nwg) return false;
        int wgid = (int)L; { const int q = nwg / NXCD, r = nwg % NXCD, xcd = wgid % NXCD, off = wgid / NXCD; wgid = (xcd < r ? xcd * (q + 1) : r * (q + 1) + (xcd - r) * q) + off; }
        const int nig = WGM * nN, gid = wgid / nig, fm = gid * WGM, gsz = (nM - fm) < WGM ? (nM - fm) : WGM;
        u.pm = fm + ((wgid % nig) % gsz); u.pn = (wgid % nig) / gsz; return true;
    }
};

template <class Epi, bool ALIGN_EPI>
__device__ __forceinline__ void gemm_phase(LAS unsigned char* lds, const Gemm g, const StaticOrder& S, const Epi& E) {
    const int tid = threadIdx.x, wid = __builtin_amdgcn_readfirstlane(tid >> 6), lane = tid & 63, wr = wid >> 2, wc = wid & 3, fr = lane & 15, fq = lane >> 4;
    const int K = g.K, nt = K / BK;
    unsigned voff[2];
#pragma unroll
    for (int i = 0; i < 2; ++i) { int R, C; stage_rc(tid * 16 + i * 8192, R, C); voff[i] = (unsigned)(R * K + C) * 2u; }
    const size_t kstep = (size_t)(BK * 2);
    const size_t hstep = (size_t)HALF * K * 2;
    const size_t tstep = 2 * hstep;
    const unsigned ldsw = (unsigned)wid * 1024u;
    const int aoff = lds_byte(wr * 64 + fr, fq * 8), boff = lds_byte(wc * 32 + fr, fq * 8);
#define PG8_SA(b, h) (((b) * 2 + (h)) * HTB)
#define PG8_SB(b, h) ((4 + (b) * 2 + (h)) * HTB)
#define PG8_STAGE(bufoff, gbase) do { _Pragma("unroll") for (int _i = 0; _i < 2; ++_i) \
        __builtin_amdgcn_global_load_lds((const unsigned*)((const char*)(gbase) + voff[_i]), (LAS unsigned*)(lds + (bufoff) + ldsw + _i * 8192), 16, 0, 0); } while (0)
#define PG8_LDA(dst, b, h) do { _Pragma("unroll") for (int m = 0; m < 4; ++m) _Pragma("unroll") for (int k = 0; k < 2; ++k) dst[m][k] = *(const LAS bf16x8*)(lds + PG8_SA(b, h) + aoff + m * 2048 + k * 1024); } while (0)
#define PG8_LDB(dst, b, h) do { _Pragma("unroll") for (int n = 0; n < 2; ++n) _Pragma("unroll") for (int k = 0; k < 2; ++k) dst[n][k] = *(const LAS bf16x8*)(lds + PG8_SB(b, h) + boff + n * 2048 + k * 1024); } while (0)
#define PG8_MMA(ai, bj, At, Bt) do { __builtin_amdgcn_s_setprio(1); _Pragma("unroll") for (int m = 0; m < 4; ++m) _Pragma("unroll") for (int n = 0; n < 2; ++n) _Pragma("unroll") for (int k = 0; k < 2; ++k) \
        acc[ai][bj][m][n] = __builtin_amdgcn_mfma_f32_16x16x32_bf16(Bt[n][k], At[m][k], acc[ai][bj][m][n], 0, 0, 0); __builtin_amdgcn_s_setprio(0); } while (0)
#define PG8_WAIT_V(n) asm volatile("s_waitcnt vmcnt(" #n ")" ::: "memory")
#define PG8_WAIT_L(n) asm volatile("s_waitcnt lgkmcnt(" #n ")" ::: "memory")
#define PG8_BAR __builtin_amdgcn_s_barrier()
#define PG8_SCHED __builtin_amdgcn_sched_barrier(0)
    Unit cur, nxt; int ui = 0;
    if (!S.next(0, cur)) return;
    LAS float* rtab = (LAS float*)(lds + RING_BYTES + 1024);
    if constexpr (Epi::USE_RINV) { if (tid < 256) rtab[tid] = E.rinv_row(cur.pm * BM + tid); }
    f32x4 acc[2][2][4][2];
#pragma unroll
    for (int a = 0; a < 2; ++a)
#pragma unroll
        for (int b = 0; b < 2; ++b)
#pragma unroll
            for (int m = 0; m < 4; ++m)
#pragma unroll
                for (int n = 0; n < 2; ++n) acc[a][b][m][n] = (f32x4){0.f, 0.f, 0.f, 0.f};
    bf16x8 At[4][2], B0[2][2], B1[2][2];
    const char* cA = (const char*)g.A + (size_t)cur.pm * tstep; const char* cB = (const char*)g.Bt + (size_t)cur.pn * tstep;
    PG8_STAGE(PG8_SB(0, 0), cB); PG8_STAGE(PG8_SB(0, 1), cB + hstep); PG8_STAGE(PG8_SA(0, 0), cA); PG8_STAGE(PG8_SA(0, 1), cA + hstep);
    if (wr == 1) PG8_BAR;
    PG8_WAIT_V(2); PG8_BAR;
    PG8_STAGE(PG8_SB(1, 0), cB + kstep); PG8_STAGE(PG8_SA(1, 0), cA + kstep); PG8_STAGE(PG8_SB(1, 1), cB + hstep + kstep);
    PG8_WAIT_V(6); PG8_BAR;
    for (;;) {
        const bool has_next = S.next(ui + 1, nxt);
        const char* nA = has_next ? (const char*)g.A + (size_t)nxt.pm * tstep : cA; const char* nB = has_next ? (const char*)g.Bt + (size_t)nxt.pn * tstep : cB;
        for (int t = 0; t < nt; t += 2) {
            const bool last = (t == nt - 2);
            const char* a1 = cA + (size_t)(t + 1) * kstep;
            const char* a2 = last ? nA : cA + (size_t)(t + 2) * kstep; const char* b2 = last ? nB : cB + (size_t)(t + 2) * kstep;
            const char* a3 = a2 + kstep; const char* b3 = b2 + kstep;
            PG8_LDB(B0, 0, 0); PG8_LDB(B1, 0, 1); PG8_SCHED; PG8_LDA(At, 0, 0); PG8_STAGE(PG8_SA(1, 1), a1 + hstep);
            PG8_WAIT_V(8); PG8_WAIT_L(0); PG8_BAR; PG8_MMA(0, 0, At, B0); PG8_MMA(0, 1, At, B1); PG8_BAR; PG8_SCHED;
            PG8_LDA(At, 0, 1); PG8_STAGE(PG8_SB(0, 0), b2); PG8_STAGE(PG8_SB(0, 1), b2 + hstep); PG8_STAGE(PG8_SA(0, 0), a2);
            PG8_WAIT_V(8); PG8_WAIT_L(0); PG8_BAR; PG8_MMA(1, 0, At, B0); PG8_MMA(1, 1, At, B1); PG8_BAR; PG8_SCHED;
            PG8_LDB(B0, 1, 0); PG8_LDB(B1, 1, 1); PG8_SCHED; PG8_LDA(At, 1, 0); PG8_STAGE(PG8_SA(0, 1), a2 + hstep);
            PG8_WAIT_V(8); PG8_WAIT_L(0); PG8_BAR; PG8_MMA(0, 0, At, B0); PG8_MMA(0, 1, At, B1); PG8_BAR; PG8_SCHED;
            PG8_LDA(At, 1, 1); PG8_STAGE(PG8_SB(1, 0), b3); PG8_STAGE(PG8_SB(1, 1), b3 + hstep); PG8_STAGE(PG8_SA(1, 0), a3);
            PG8_WAIT_V(8); PG8_WAIT_L(0); PG8_BAR; PG8_MMA(1, 0, At, B0); PG8_MMA(1, 1, At, B1); PG8_BAR; PG8_SCHED;
        }
        if constexpr (ALIGN_EPI) { if (wr == 0) PG8_BAR; }
        float rnext = 0.f;
        if constexpr (Epi::USE_RINV) { if (has_next && tid < 256) rnext = E.rinv_row(nxt.pm * BM + tid); }
        E(acc, cur, wr, wc, fr, fq, rtab + (ui & 1) * 256);
        if constexpr (Epi::USE_RINV) { if (has_next && tid < 256) rtab[((ui + 1) & 1) * 256 + tid] = rnext; }
        if (!has_next) break;
#pragma unroll
        for (int a = 0; a < 2; ++a)
#pragma unroll
            for (int b = 0; b < 2; ++b)
#pragma unroll
                for (int m = 0; m < 4; ++m)
#pragma unroll
                    for (int n = 0; n < 2; ++n) acc[a][b][m][n] = (f32x4){0.f, 0.f, 0.f, 0.f};
        cur = nxt; cA = nA; cB = nB; ++ui;
        if constexpr (ALIGN_EPI) { if (wr == 1) PG8_BAR; }
    }
    PG8_WAIT_V(0);
    if constexpr (!ALIGN_EPI) { if (wr == 0) PG8_BAR; }
    PG8_BAR;
#undef PG8_SA
#undef PG8_SB
#undef PG8_STAGE
#undef PG8_LDA
#undef PG8_LDB
#undef PG8_MMA
#undef PG8_WAIT_V
#undef PG8_WAIT_L
#undef PG8_BAR
#undef PG8_SCHED
}
}
namespace fk {
struct Args {
    const float* in[24]; float* out; unsigned char* ws_; int ph_lo, ph_hi;
    __device__ __forceinline__ const float* x_prompt() const { return in[0]; }
    __device__ __forceinline__ const float* x_sample() const { return in[1]; }
    __device__ __forceinline__ const float* cache_k() const { return in[2]; }
    __device__ __forceinline__ const float* cache_v() const { return in[3]; }
    __device__ __forceinline__ const float* state_hgrn() const { return in[4]; }
    __device__ __forceinline__ const float* norm_mix() const { return in[5]; }
    __device__ __forceinline__ const float* norm_ffn() const { return in[6]; }
    __device__ __forceinline__ const float* w_in_ab() const { return in[7]; }
    __device__ __forceinline__ const float* w_out_ab() const { return in[8]; }
    __device__ __forceinline__ const float* q_norm() const { return in[9]; }
    __device__ __forceinline__ const float* k_norm() const { return in[10]; }
    __device__ __forceinline__ const float* attn_sink() const { return in[11]; }
    __device__ __forceinline__ const float* rel_bias() const { return in[12]; }
    __device__ __forceinline__ const float* gmlp_ln_g() const { return in[13]; }
    __device__ __forceinline__ const float* gmlp_ln_b() const { return in[14]; }
    __device__ __forceinline__ const float* gmlp_w_s() const { return in[15]; }
    __device__ __forceinline__ const float* gmlp_b_s() const { return in[16]; }
    __device__ __forceinline__ const float* w_in_c() const { return in[17]; }
    __device__ __forceinline__ const float* c_lb() const { return in[18]; }
    __device__ __forceinline__ const float* c_out_norm() const { return in[19]; }
    __device__ __forceinline__ const float* w_out_c() const { return in[20]; }
    __device__ __forceinline__ const float* w_gate() const { return in[21]; }
    __device__ __forceinline__ const float* w_up() const { return in[22]; }
    __device__ __forceinline__ const float* w_down() const { return in[23]; }
    __device__ __forceinline__ unsigned char* ws() const { return ws_; }
    __device__ __forceinline__ float* X() const { return out; }
    __device__ __forceinline__ float* nkp() const { return out + (size_t)MTOT * DM; }
    __device__ __forceinline__ float* nvp() const { return nkp() + 4 * 128 * 128; }
    __device__ __forceinline__ float* nks() const { return nvp() + 4 * 128 * 128; }
    __device__ __forceinline__ float* nvs() const { return nks() + (size_t)128 * 128 * 128; }
    __device__ __forceinline__ float* gvp() const { return nvs() + (size_t)128 * 128 * 128; }
    __device__ __forceinline__ float* gvs() const { return gvp() + 4 * 128 * 512; }
    __device__ __forceinline__ float* stp() const { return gvs() + 128 * 512; }
    __device__ __forceinline__ float* sts() const { return stp() + (size_t)4 * 8 * 16384; }
};

__device__ __forceinline__ int slot_col(int map, int np, int& which) {
    const int pn = np >> 8, s = np & 255, bj = s >> 7, wc = (s >> 5) & 3, n = (s >> 4) & 1, fq = (s >> 2) & 3, e = s & 3;
    which = 0;
    if (map == 0) return 256 * pn + 64 * wc + 32 * bj + 8 * fq + 4 * n + e;
    if (map == 1) return 256 * pn + 128 * bj + 32 * wc + 8 * fq + 4 * n + e;
    which = n; return 128 * pn + 32 * wc + 8 * fq + 4 * bj + e;
}
__device__ __forceinline__ void wconv_item(LAS unsigned char* lds, const float* w_s0, const float* w_s1, const int w_srcN, const float* w_gs, bf16_t* w_dst, const int w_K, const int w_map, const int w_nnt, int item) {
    const int tid = threadIdx.x, lane = tid & 63, wv = tid >> 6;
    const int nt = item % w_nnt, kt = item / w_nnt, n0 = nt * 64, k0 = kt * 64;
    LAS bf16_t* T = (LAS bf16_t*)lds;
    int which; const int col = slot_col(w_map, n0 + lane, which);
    const float* src = which ? w_s1 : w_s0;
#pragma unroll
    for (int j = 0; j < 8; ++j) {
        const int k = k0 + wv * 8 + j;
        float v = src[(size_t)k * w_srcN + col];
        if (w_gs) v *= w_gs[k];
        T[lane * 66 + wv * 8 + j] = f2bf(v);
    }
    __syncthreads();
    {
        const int row = tid >> 3, ch = tid & 7;
        const LAS unsigned* p = (const LAS unsigned*)(T + row * 66 + ch * 8);
        u32x4 o; o.x = p[0]; o.y = p[1]; o.z = p[2]; o.w = p[3];
        *(u32x4*)(w_dst + (size_t)(n0 + row) * w_K + k0 + ch * 8) = o;
    }
    __syncthreads();
}
__device__ __forceinline__ void p0_prologue(const Args& P, LAS unsigned char* lds) {
    const int tid = threadIdx.x, lane = tid & 63, wv = tid >> 6, blk = blockIdx.x, G = gridDim.x;
    unsigned char* ws = P.ws();
    {
    int base = 0;
#define WCONV(S0, S1, SRCN, GS, DST, KK, NSL, MAP) do { const int nit_ = ((NSL) / 64) * ((KK) / 64); \
        for (int i_ = (blk - base % G + G) % G; i_ < nit_; i_ += G) wconv_item(lds, S0, S1, SRCN, GS, (bf16_t*)(ws + (DST)), KK, MAP, (NSL) / 64, i_); base += nit_; } while (0)
    WCONV(P.w_in_ab(), nullptr, N_INAB, P.norm_mix(), WS_W_INAB, DM, N_INAB, 0);
    WCONV(P.w_out_ab(), nullptr, DM, nullptr, WS_W_OUTAB, DM, DM, 1);
    WCONV(P.w_gate(), P.w_up(), FF, P.norm_ffn(), WS_W_GU0, DM, N_GU, 2);
    WCONV(P.w_gate() + (size_t)DM * FF, P.w_up() + (size_t)DM * FF, FF, P.norm_ffn() + DM, WS_W_GU1, DM, N_GU, 2);
#undef WCONV
    }
    bf16_t* XB = (bf16_t*)P.X();
    float* SS = (float*)(ws + WS_SS);
    for (int row = blk * 8 + wv; row < MTOT; row += G * 8) {
        const float* xr = (row < MP) ? P.x_prompt() + (size_t)row * DM : P.x_sample() + (size_t)(row - MP) * DM;
        float s = 0.f;
#pragma unroll
        for (int j = 0; j < 4; ++j) {
            const f32x4 v = *(const f32x4*)(xr + 4 * lane + 256 * j);
            s += (v[0] * v[0] + v[1] * v[1]) + (v[2] * v[2] + v[3] * v[3]);
            *(u32x2*)(XB + (size_t)row * DM + 4 * lane + 256 * j) = pack4(v);
        }
        s = wsum(s);
        if (lane < 32) SS[(size_t)row * 32 + lane] = (lane == 0) ? s : 0.f;
    }
    if (blk == 0) {
        float* B2 = (float*)(ws + WS_BIAS2);
        for (int i = tid; i < 8 * 128; i += 512) { const int h = i >> 7, d = i & 127; B2[i] = P.rel_bias()[T5B[d] * 8 + h] * LOG2E; }
        float* LBT = (float*)(ws + WS_LBT);
        for (int i = tid; i < 1024; i += 512) { const float c0 = P.c_lb()[i], c1 = P.c_lb()[1024 + i]; LBT[i] = 1.f / (1.f + expf(c0 - c1)); }
    }
    if (blk >= 1 && blk < 9) {
        const int g = blk - 1; bf16_t* WT = (bf16_t*)(ws + WS_WTRIL) + (size_t)g * 128 * 128; const float* wsrc = P.gmlp_w_s() + (size_t)g * 128 * 128;
        for (int i = tid; i < 128 * 128; i += 512) { const int t = i >> 7, s = i & 127; WT[i] = (s <= t) ? f2bf(wsrc[i]) : (bf16_t)0; }
    }
}

__device__ __forceinline__ void wconv_deferred(const Args& P, LAS unsigned char* lds, int which, int first) {
    const int blk = blockIdx.x, G = gridDim.x, nb = G - first, me = blk - first;
    if (me < 0) return;
    unsigned char* ws = P.ws();
    if (which == 0) { for (int i = me; i < 16 * 44; i += nb) wconv_item(lds, P.w_down(), nullptr, DM, nullptr, (bf16_t*)(ws + WS_W_DN0), FF, 1, 16, i); }
    else if (which == 1) {
        for (int i = me; i < 64 * 16; i += nb) wconv_item(lds, P.w_in_c(), nullptr, N_INC, P.norm_mix() + DM, (bf16_t*)(ws + WS_W_INC), DM, 1, 64, i);
        for (int i = me; i < 16 * 16; i += nb) wconv_item(lds, P.w_out_c(), nullptr, DM, nullptr, (bf16_t*)(ws + WS_W_OUTC), DM, 1, 16, i);
    } else { for (int i = me; i < 16 * 44; i += nb) wconv_item(lds, P.w_down() + (size_t)FF * DM, nullptr, DM, nullptr, (bf16_t*)(ws + WS_W_DN1), FF, 1, 16, i); }
}

__device__ __forceinline__ float row_rinv(const float* SS, int row) {
    const f32x4* p = (const f32x4*)(SS + (size_t)row * 32);
    float s = 0.f;
#pragma unroll
    for (int i = 0; i < 8; ++i) { const f32x4 a = p[i]; s += (a[0] + a[1]) + (a[2] + a[3]); }
    return rsqrtf(s * (1.f / DM) + EPS);
}
__device__ __forceinline__ float sum4(f32x4 v) { return (v[0] + v[1]) + (v[2] + v[3]); }
__device__ __forceinline__ float sumsq4(f32x4 v) { return (v[0] * v[0] + v[1] * v[1]) + (v[2] * v[2] + v[3] * v[3]); }

struct EpiInAb {
    static constexpr bool USE_RINV = true;
    __device__ __forceinline__ float rinv_row(int row) const { return row_rinv(SS, row); }
    const float* SS; bf16_t *Q, *K, *V, *U, *GV; float* LNS; const float *qn, *kn; float *nkp, *nvp, *nks, *nvs;
    __device__ __forceinline__ void operator()(const f32x4 (&acc)[2][2][4][2], const Unit& u, int wr, int wc, int fr, int fq, const LAS float* rt) const {
        const int pn = u.pn;
#pragma unroll
        for (int ai = 0; ai < 2; ++ai)
#pragma unroll
            for (int m = 0; m < 4; ++m) {
                const int row = u.pm * BM + ai * HALF + wr * 64 + m * 16 + fr;
                if (row >= MTOT) continue;
                const float rinv = rt[ai * HALF + wr * 64 + m * 16 + fr];
                f32x4 v[2][2];
#pragma unroll
                for (int bj = 0; bj < 2; ++bj)
#pragma unroll
                    for (int n = 0; n < 2; ++n) v[bj][n] = acc[ai][bj][m][n] * rinv;
                const int d0 = 8 * fq;
                if (pn < 2 || (pn == 2 && wc < 2)) {
                    float ss = (sumsq4(v[0][0]) + sumsq4(v[0][1])) + (sumsq4(v[1][0]) + sumsq4(v[1][1]));
                    ss += __shfl_xor(ss, 16); ss += __shfl_xor(ss, 32);
                    const float r = rsqrtf(ss * (1.f / 64.f) + EPS);
                    const bool isq = pn < 2;
                    const float* nw = isq ? qn : kn;
                    const float sc = isq ? r * (0.125f * LOG2E) : r;
                    bf16_t* dst = isq ? Q + (size_t)row * 512 + (4 * pn + wc) * 64 : K + (size_t)row * 128 + wc * 64;
                    float* fo = nullptr;
                    if (!isq) {
                        if ((u.pm & 15) == 15 && ai == 1) { const int b = u.pm >> 4, i = row - (b * SEQ + SEQ - 128); fo = nkp + ((size_t)(b * 128 + i) * 2 + wc) * 64; }
                        if (u.pm == 64) { const int b = row - MP; fo = nks + ((size_t)(b * 128 + 127) * 2 + wc) * 64; }
                    }
#pragma unroll
                    for (int bj = 0; bj < 2; ++bj) {
                        const f32x4 w0 = *(const f32x4*)(nw + 32 * bj + d0), w1 = *(const f32x4*)(nw + 32 * bj + d0 + 4);
                        const f32x4 o0 = v[bj][0] * w0 * sc, o1 = v[bj][1] * w1 * sc;
                        *(u32x4*)(dst + 32 * bj + d0) = pack8(o0, o1);
                        if (fo) { *(f32x4*)(fo + 32 * bj + d0) = o0; *(f32x4*)(fo + 32 * bj + d0 + 4) = o1; }
                    }
                } else if (pn == 2) {
                    const int kvh = wc - 2;
                    bf16_t* dst = V + (size_t)row * 128 + kvh * 64;
                    float* fo = nullptr;
                    if ((u.pm & 15) == 15 && ai == 1) { const int b = u.pm >> 4, i = row - (b * SEQ + SEQ - 128); fo = nvp + ((size_t)(b * 128 + i) * 2 + kvh) * 64; }
                    if (u.pm == 64) { const int b = row - MP; fo = nvs + ((size_t)(b * 128 + 127) * 2 + kvh) * 64; }
#pragma unroll
                    for (int bj = 0; bj < 2; ++bj) {
                        *(u32x4*)(dst + 32 * bj + d0) = pack8(v[bj][0], v[bj][1]);
                        if (fo) { *(f32x4*)(fo + 32 * bj + d0) = v[bj][0]; *(f32x4*)(fo + 32 * bj + d0 + 4) = v[bj][1]; }
                    }
                } else if (pn < 5) {
                    bf16_t* dst = U + (size_t)row * 512 + (pn - 3) * 256 + wc * 64;
#pragma unroll
                    for (int bj = 0; bj < 2; ++bj) *(u32x4*)(dst + 32 * bj + d0) = pack8(gelu4(v[bj][0]), gelu4(v[bj][1]));
                } else {
                    bf16_t* dst = GV + (size_t)row * 512 + (pn - 5) * 256 + wc * 64;
                    float s1 = 0.f, s2 = 0.f;
#pragma unroll
                    for (int bj = 0; bj < 2; ++bj) {
                        const f32x4 g0 = gelu4(v[bj][0]), g1 = gelu4(v[bj][1]);
                        s1 += sum4(g0) + sum4(g1); s2 += sumsq4(g0) + sumsq4(g1);
                        *(u32x4*)(dst + 32 * bj + d0) = pack8(g0, g1);
                    }
                    s1 += __shfl_xor(s1, 16); s1 += __shfl_xor(s1, 32);
                    s2 += __shfl_xor(s2, 16); s2 += __shfl_xor(s2, 32);
                    if (fq == 0) *(f32x2*)(LNS + (size_t)row * 16 + ((pn - 5) * 4 + wc) * 2) = (f32x2){s1, s2};
                }
            }
    }
};

template <int MODE> struct EpiRes {
    static constexpr bool USE_RINV = false;
    __device__ __forceinline__ float rinv_row(int) const { return 0.f; }
    const float* xin_p; const float* xin_s; const bf16_t* RB_;
    bf16_t* OB; float* OF; float* SS;
    __device__ __forceinline__ void operator()(const f32x4 (&acc)[2][2][4][2], const Unit& u, int wr, int wc, int fr, int fq, const LAS float* rt) const {
#pragma unroll
        for (int ai = 0; ai < 2; ++ai) {
            f32x4 pre[4][2][2];
#pragma unroll
            for (int m = 0; m < 4; ++m) {
                const int row = u.pm * BM + ai * HALF + wr * 64 + m * 16 + fr;
                const int rr = row < MTOT ? row : 0;
#pragma unroll
                for (int bj = 0; bj < 2; ++bj) {
                    const int c0 = u.pn * BM + bj * HALF + wc * 32 + 8 * fq;
                    if (MODE == 0) {
                        const float* src = (rr < MP) ? xin_p + (size_t)rr * DM : xin_s + (size_t)(rr - MP) * DM;
                        pre[m][bj][0] = *(const f32x4*)(src + c0); pre[m][bj][1] = *(const f32x4*)(src + c0 + 4);
                    } else {
                        const u32x4 w = *(const u32x4*)(RB_ + (size_t)rr * DM + c0);
                        pre[m][bj][0] = (f32x4){bflo(w.x), bfhi(w.x), bflo(w.y), bfhi(w.y)}; pre[m][bj][1] = (f32x4){bflo(w.z), bfhi(w.z), bflo(w.w), bfhi(w.w)};
                    }
                }
            }
            asm volatile("" ::: "memory");
#pragma unroll
            for (int m = 0; m < 4; ++m) {
                const int row = u.pm * BM + ai * HALF + wr * 64 + m * 16 + fr;
                if (row >= MTOT) continue;
                float ss = 0.f;
#pragma unroll
                for (int bj = 0; bj < 2; ++bj) {
                    const int c0 = u.pn * BM + bj * HALF + wc * 32 + 8 * fq;
                    const f32x4 o0 = pre[m][bj][0] + acc[ai][bj][m][0], o1 = pre[m][bj][1] + acc[ai][bj][m][1];
                    if (MODE == 2) { *(f32x4*)(OF + (size_t)row * DM + c0) = o0; *(f32x4*)(OF + (size_t)row * DM + c0 + 4) = o1; }
                    else { *(u32x4*)(OB + (size_t)row * DM + c0) = pack8(o0, o1); ss += sumsq4(o0) + sumsq4(o1); }
                }
                if (MODE != 2) {
                    ss += __shfl_xor(ss, 16); ss += __shfl_xor(ss, 32);
                    if (fq == 0) SS[(size_t)row * 32 + u.pn * 4 + wc] = ss;
                }
            }
            asm volatile("" ::: "memory");
        }
    }
};

struct EpiGU {
    static constexpr bool USE_RINV = true;
    __device__ __forceinline__ float rinv_row(int row) const { return row_rinv(SS, row); }
    const float* SS; bf16_t* HID;
    __device__ __forceinline__ void operator()(const f32x4 (&acc)[2][2][4][2], const Unit& u, int wr, int wc, int fr, int fq, const LAS float* rt) const {
#pragma unroll
        for (int ai = 0; ai < 2; ++ai)
#pragma unroll
            for (int m = 0; m < 4; ++m) {
                const int row = u.pm * BM + ai * HALF + wr * 64 + m * 16 + fr;
                if (row >= MTOT) continue;
                const float rinv = rt[ai * HALF + wr * 64 + m * 16 + fr];
                f32x4 h[2];
#pragma unroll
                for (int bj = 0; bj < 2; ++bj) {
                    const f32x4 g = acc[ai][bj][m][0] * rinv, up = acc[ai][bj][m][1] * rinv;
#pragma unroll
                    for (int e = 0; e < 4; ++e) h[bj][e] = g[e] * sigm(g[e]) * up[e];
                }
                *(u32x4*)(HID + (size_t)row * FF + u.pn * 128 + wc * 32 + 8 * fq) = pack8(h[0], h[1]);
            }
    }
};

struct EpiInC {
    static constexpr bool USE_RINV = true;
    __device__ __forceinline__ float rinv_row(int row) const { return row_rinv(SS, row); }
    const float* SS; const float* LBT; bf16_t *Q1, *K1, *I1, *SG1; unsigned short* LF;
    __device__ __forceinline__ void operator()(const f32x4 (&acc)[2][2][4][2], const Unit& u, int wr, int wc, int fr, int fq, const LAS float* rt) const {
        const int type = u.pn >> 2, cb = (u.pn & 3) * 256;
#pragma unroll
        for (int ai = 0; ai < 2; ++ai)
#pragma unroll
            for (int m = 0; m < 4; ++m) {
                const int row = u.pm * BM + ai * HALF + wr * 64 + m * 16 + fr;
                if (row >= MTOT) continue;
                const float rinv = rt[ai * HALF + wr * 64 + m * 16 + fr];
#pragma unroll
                for (int bj = 0; bj < 2; ++bj) {
                    const int c0 = cb + bj * HALF + wc * 32 + 8 * fq;
                    const f32x4 v0 = acc[ai][bj][m][0] * rinv, v1 = acc[ai][bj][m][1] * rinv;
                    const size_t off = (size_t)row * DM + c0;
                    if (type == 0) *(u32x4*)(Q1 + off) = pack8(v0, v1);
                    else if (type == 2) *(u32x4*)(I1 + off) = pack8(v0, v1);
                    else if (type == 3) {
                        f32x4 s0, s1;
#pragma unroll
                        for (int e = 0; e < 4; ++e) { s0[e] = sigm(v0[e]); s1[e] = sigm(v1[e]); }
                        *(u32x4*)(SG1 + off) = pack8(s0, s1);
                    } else {
                        const f32x4 l0 = *(const f32x4*)(LBT + c0), l1 = *(const f32x4*)(LBT + c0 + 4);
                        u32x4 lw;
                        float lf[8];
#pragma unroll
                        for (int e = 0; e < 4; ++e) {
                            const float f0 = l0[e] + (1.f - l0[e]) * sigm(v0[e]), f1 = l1[e] + (1.f - l1[e]) * sigm(v1[e]);
                            lf[e] = f0; lf[4 + e] = f1;
                        }
                        lw.x = (unsigned)f2h(lf[0]) | ((unsigned)f2h(lf[1]) << 16); lw.y = (unsigned)f2h(lf[2]) | ((unsigned)f2h(lf[3]) << 16);
                        lw.z = (unsigned)f2h(lf[4]) | ((unsigned)f2h(lf[5]) << 16); lw.w = (unsigned)f2h(lf[6]) | ((unsigned)f2h(lf[7]) << 16);
                        *(u32x4*)(LF + off) = lw;
                    }
                }
            }
    }
};
}
namespace fk {
__device__ __forceinline__ void attn_prompt_unit(const Args& P, LAS unsigned char* lds, int b, int qb, int kvh) {
    const int tid = threadIdx.x, lane = tid & 63, w = __builtin_amdgcn_readfirstlane(tid >> 6), li = lane & 15, gq = lane >> 4;
    unsigned char* ws = P.ws();
    const bf16_t* Q = (const bf16_t*)(ws + WS_B + B_Q0); const bf16_t* K = (const bf16_t*)(ws + WS_B + B_K0); const bf16_t* V = (const bf16_t*)(ws + WS_B + B_V0);
    bf16_t* MIX = (bf16_t*)(ws + WS_A);
    LAS bf16_t* KS = (LAS bf16_t*)lds;
    LAS bf16_t* VT = (LAS bf16_t*)(lds + 36864);
    LAS float* B2 = (LAS float*)(lds + 36864 + 33280);
    LAS float* SK = B2 + 512;
    const int rowbase = b * SEQ + qb * 128 - 128;
    bf16x8 qn0, qn1;
    const bf16_t* qbase = Q + ((size_t)b * SEQ + qb * 128 + 64 * (w & 1) + li) * 512 + (4 * kvh + (w >> 1)) * 64 + 8 * gq;
    qn0 = *(const bf16x8*)(qbase); qn1 = *(const bf16x8*)(qbase + 32);
#pragma unroll
    for (int i = 0; i < 4; ++i) {
        const int p = tid + 512 * i, j = p >> 3, ch = p & 7;
        u32x4 kv4 = (u32x4){0u, 0u, 0u, 0u}, vv4 = (u32x4){0u, 0u, 0u, 0u};
        if (qb > 0 || j >= 128) {
            kv4 = *(const u32x4*)(K + (size_t)(rowbase + j) * 128 + kvh * 64 + ch * 8);
            vv4 = *(const u32x4*)(V + (size_t)(rowbase + j) * 128 + kvh * 64 + ch * 8);
        }
        *(LAS u32x4*)(KS + j * 72 + ch * 8) = kv4;
        LAS bf16_t* vt = VT + (ch * 8) * 260 + j;
        vt[0 * 260] = (bf16_t)(vv4.x & 0xffffu); vt[1 * 260] = (bf16_t)(vv4.x >> 16);
        vt[2 * 260] = (bf16_t)(vv4.y & 0xffffu); vt[3 * 260] = (bf16_t)(vv4.y >> 16);
        vt[4 * 260] = (bf16_t)(vv4.z & 0xffffu); vt[5 * 260] = (bf16_t)(vv4.z >> 16);
        vt[6 * 260] = (bf16_t)(vv4.w & 0xffffu); vt[7 * 260] = (bf16_t)(vv4.w >> 16);
    }
    { const float* B2g = (const float*)(ws + WS_BIAS2); B2[tid] = B2g[(4 * kvh + (tid >> 7)) * 128 + (tid & 127)]; if (tid < 4) SK[tid] = P.attn_sink()[4 * kvh + tid] * LOG2E; }
    __syncthreads();
    const int g = w >> 1, h = 4 * kvh + g;
    const float sk2 = SK[g];
    for (int a4 = 0; a4 < 4; ++a4) {
        const int a = 4 * (w & 1) + a4;
        const size_t qrow = (size_t)b * SEQ + qb * 128 + 16 * a + li;
        bf16x8 qf[2];
        qf[0] = qn0; qf[1] = qn1;
        { const int an = a4 < 3 ? a4 + 1 : a4; qn0 = *(const bf16x8*)(qbase + (size_t)(16 * an) * 512); qn1 = *(const bf16x8*)(qbase + (size_t)(16 * an) * 512 + 32); }
        const int sb0 = 2 * (a >> 1);
        f32x4 st[10];
#pragma unroll
        for (int i = 0; i < 10; ++i) {
            st[i] = (f32x4){0.f, 0.f, 0.f, 0.f};
#pragma unroll
            for (int ks = 0; ks < 2; ++ks) {
                const bf16x8 kf = *(const LAS bf16x8*)(KS + (16 * (sb0 + i) + li) * 72 + 32 * ks + 8 * gq);
                st[i] = mfma16(kf, qf[ks], st[i]);
            }
        }
        const int iq = 16 * a + li;
        float mx = -INFINITY;
#pragma unroll
        for (int i = 0; i < 10; ++i)
#pragma unroll
            for (int r = 0; r < 4; ++r) {
                const int s = 16 * (sb0 + i) + 4 * gq + r, dist = iq + 128 - s;
                const bool valid = ((unsigned)dist < 128u) && (qb > 0 || s >= 128);
                const float val = valid ? st[i][r] + B2[g * 128 + (dist & 127)] : -INFINITY;
                st[i][r] = val; mx = fmaxf(mx, val);
            }
        mx = fmaxf(mx, __shfl_xor(mx, 16)); mx = fmaxf(mx, __shfl_xor(mx, 32)); mx = fmaxf(mx, sk2);
        float l = 0.f;
#pragma unroll
        for (int i = 0; i < 10; ++i)
#pragma unroll
            for (int r = 0; r < 4; ++r) { const float p = ex2(st[i][r] - mx); st[i][r] = p; l += p; }
        l += __shfl_xor(l, 16); l += __shfl_xor(l, 32); l += ex2(sk2 - mx);
        f32x4 ot[4];
#pragma unroll
        for (int db = 0; db < 4; ++db) ot[db] = (f32x4){0.f, 0.f, 0.f, 0.f};
#pragma unroll
        for (int t = 0; t < 5; ++t) {
            const u32x4 pw = pack8(st[2 * t], st[2 * t + 1]);
            const bf16x8 pf = __builtin_bit_cast(bf16x8, pw);
#pragma unroll
            for (int db = 0; db < 4; ++db) {
                const LAS bf16_t* vp = VT + (16 * db + li) * 260 + 16 * (sb0 + 2 * t) + 4 * gq;
                const u32x2 lo = *(const LAS u32x2*)vp, hi = *(const LAS u32x2*)(vp + 16);
                const u32x4 vw = (u32x4){lo.x, lo.y, hi.x, hi.y};
                ot[db] = mfma16(__builtin_bit_cast(bf16x8, vw), pf, ot[db]);
            }
        }
        const float inv = 1.f / l;
#pragma unroll
        for (int db = 0; db < 4; ++db) *(u32x2*)(MIX + qrow * DM + h * 64 + 16 * db + 4 * gq) = pack4(ot[db] * inv);
    }
    __syncthreads();
}

__device__ __forceinline__ void gmlp_unit(const Args& P, LAS unsigned char* lds, int b, int chunk, int ghalf) {
    const int tid = threadIdx.x, lane = tid & 63, w = __builtin_amdgcn_readfirstlane(tid >> 6), li = lane & 15, gq = lane >> 4;
    unsigned char* ws = P.ws();
    const bf16_t* U = (const bf16_t*)(ws + WS_B + B_U0); const bf16_t* GV = (const bf16_t*)(ws + WS_B + B_GV0);
    const float* LNS = (const float*)(ws + WS_LNS); const bf16_t* WT = (const bf16_t*)(ws + WS_WTRIL);
    bf16_t* MIX = (bf16_t*)(ws + WS_A);
    LAS float* STAT = (LAS float*)lds;
    const int gi = w >> 1, grp = 4 * ghalf + gi;
    LAS bf16_t* VTg = (LAS bf16_t*)(lds + 1024 + gi * 17408);
    const int r0 = b * SEQ + chunk * 128;
    u32x4 gwa[8];
#pragma unroll
    for (int i = 0; i < 8; ++i) { const int p = (w & 1) * 512 + lane + 64 * i, s = p >> 3, ch = p & 7; gwa[i] = *(const u32x4*)(GV + (size_t)(r0 + s) * 512 + grp * 64 + ch * 8); }
    if (tid < 128) {
        const float* p = LNS + (size_t)(r0 + tid) * 16;
        float s1 = 0.f, s2 = 0.f;
#pragma unroll
        for (int q = 0; q < 8; ++q) { s1 += p[2 * q]; s2 += p[2 * q + 1]; }
        const float mean = s1 * (1.f / 512.f), var = fmaxf(s2 * (1.f / 512.f) - mean * mean, 0.f);
        STAT[2 * tid] = mean; STAT[2 * tid + 1] = rsqrtf(var + EPS);
    }
    __syncthreads();
    const bool lastc = (chunk == SEQ / 128 - 1);
#pragma unroll
    for (int i = 0; i < 8; ++i) {
        const int p = (w & 1) * 512 + lane + 64 * i, s = p >> 3, ch = p & 7;
        const u32x4 gw = gwa[i];
        const float mean = STAT[2 * s], rstd = STAT[2 * s + 1];
        const f32x4 g0 = *(const f32x4*)(P.gmlp_ln_g() + grp * 64 + ch * 8), g1 = *(const f32x4*)(P.gmlp_ln_g() + grp * 64 + ch * 8 + 4);
        const f32x4 b0 = *(const f32x4*)(P.gmlp_ln_b() + grp * 64 + ch * 8), b1 = *(const f32x4*)(P.gmlp_ln_b() + grp * 64 + ch * 8 + 4);
        f32x4 v0, v1;
        v0[0] = (bflo(gw.x) - mean) * rstd * g0[0] + b0[0]; v0[1] = (bfhi(gw.x) - mean) * rstd * g0[1] + b0[1];
        v0[2] = (bflo(gw.y) - mean) * rstd * g0[2] + b0[2]; v0[3] = (bfhi(gw.y) - mean) * rstd * g0[3] + b0[3];
        v1[0] = (bflo(gw.z) - mean) * rstd * g1[0] + b1[0]; v1[1] = (bfhi(gw.z) - mean) * rstd * g1[1] + b1[1];
        v1[2] = (bflo(gw.w) - mean) * rstd * g1[2] + b1[2]; v1[3] = (bfhi(gw.w) - mean) * rstd * g1[3] + b1[3];
        LAS bf16_t* vt = VTg + (ch * 8) * 136 + s;
#pragma unroll
        for (int e = 0; e < 4; ++e) { vt[e * 136] = f2bf(v0[e]); vt[(4 + e) * 136] = f2bf(v1[e]); }
        if (lastc) { float* o = P.gvp() + ((size_t)(b * 128 + s) * 512) + grp * 64 + ch * 8; *(f32x4*)o = v0; *(f32x4*)(o + 4) = v1; }
    }
    __syncthreads();
    for (int tb = 0; tb < 8; ++tb) {
        const int nks = (tb >> 1) + 1;
        f32x4 acc[2] = {(f32x4){0.f, 0.f, 0.f, 0.f}, (f32x4){0.f, 0.f, 0.f, 0.f}};
        for (int ks = 0; ks < nks; ++ks) {
            const bf16x8 wf = *(const bf16x8*)(WT + ((size_t)grp * 128 + 16 * tb + li) * 128 + 32 * ks + 8 * gq);
#pragma unroll
            for (int ci = 0; ci < 2; ++ci) {
                const int cbk = 2 * (w & 1) + ci;
                const bf16x8 vf = *(const LAS bf16x8*)(VTg + (16 * cbk + li) * 136 + 32 * ks + 8 * gq);
                acc[ci] = mfma16(vf, wf, acc[ci]);
            }
        }
        const int t = 16 * tb + li;
        const float bias = P.gmlp_b_s()[grp * 128 + t];
#pragma unroll
        for (int ci = 0; ci < 2; ++ci) {
            const int cbk = 2 * (w & 1) + ci, c = grp * 64 + 16 * cbk + 4 * gq;
            const u32x2 uw = *(const u32x2*)(U + (size_t)(r0 + t) * 512 + c);
            f32x4 o; o[0] = bflo(uw.x) * (acc[ci][0] + bias); o[1] = bfhi(uw.x) * (acc[ci][1] + bias); o[2] = bflo(uw.y) * (acc[ci][2] + bias); o[3] = bfhi(uw.y) * (acc[ci][3] + bias);
            *(u32x2*)(MIX + (size_t)(r0 + t) * DM + 512 + c) = pack4(o);
        }
    }
    __syncthreads();
}

__device__ __forceinline__ void attn_sample_wave(const Args& P, LAS float* scr  , int b, int kvh) {
    const int lane = threadIdx.x & 63;
    unsigned char* ws = P.ws();
    const bf16_t* Q = (const bf16_t*)(ws + WS_B + B_Q0); bf16_t* MIX = (bf16_t*)(ws + WS_A); const float* B2g = (const float*)(ws + WS_BIAS2);
    LAS float* qs = scr; LAS float* ps = scr + 256;
    const size_t row = (size_t)MP + b;
#pragma unroll
    for (int hh = 0; hh < 4; ++hh) qs[hh * 64 + lane] = bf2f(Q[row * 512 + (4 * kvh + hh) * 64 + lane]);
    float sc[2][4];
#pragma unroll
    for (int i = 0; i < 2; ++i) {
        const int a = lane + 64 * i;
        const float* kp = (a < 127) ? P.cache_k() + ((size_t)(b * 128 + a + 1) * 2 + kvh) * 64 : P.nks() + ((size_t)(b * 128 + 127) * 2 + kvh) * 64;
        float* ko = P.nks() + ((size_t)(b * 128 + (a < 127 ? a : 127)) * 2 + kvh) * 64;
        float d0 = 0.f, d1 = 0.f, d2 = 0.f, d3 = 0.f;
#pragma unroll 4
        for (int c = 0; c < 16; ++c) {
            const f32x4 k4 = *(const f32x4*)(kp + 4 * c);
            if (a < 127) *(f32x4*)(ko + 4 * c) = k4;
            const f32x4 q0 = *(const LAS f32x4*)(qs + 4 * c), q1 = *(const LAS f32x4*)(qs + 64 + 4 * c), q2 = *(const LAS f32x4*)(qs + 128 + 4 * c), q3 = *(const LAS f32x4*)(qs + 192 + 4 * c);
            d0 += (q0[0] * k4[0] + q0[1] * k4[1]) + (q0[2] * k4[2] + q0[3] * k4[3]);
            d1 += (q1[0] * k4[0] + q1[1] * k4[1]) + (q1[2] * k4[2] + q1[3] * k4[3]);
            d2 += (q2[0] * k4[0] + q2[1] * k4[1]) + (q2[2] * k4[2] + q2[3] * k4[3]);
            d3 += (q3[0] * k4[0] + q3[1] * k4[1]) + (q3[2] * k4[2] + q3[3] * k4[3]);
        }
        const float* bb = B2g + (4 * kvh) * 128 + (127 - a);
        sc[i][0] = d0 + bb[0]; sc[i][1] = d1 + bb[128]; sc[i][2] = d2 + bb[256]; sc[i][3] = d3 + bb[384];
        asm volatile("" ::: "memory");
    }
    float linv[4];
#pragma unroll
    for (int hh = 0; hh < 4; ++hh) {
        const float sk2 = P.attn_sink()[4 * kvh + hh] * LOG2E;
        const float mx = fmaxf(wmax(fmaxf(sc[0][hh], sc[1][hh])), sk2);
        const float p0 = ex2(sc[0][hh] - mx), p1 = ex2(sc[1][hh] - mx);
        const float l = wsum(p0 + p1) + ex2(sk2 - mx);
        linv[hh] = 1.f / l;
        ps[hh * 128 + lane] = p0; ps[hh * 128 + 64 + lane] = p1;
    }
    float o[4] = {0.f, 0.f, 0.f, 0.f};
#pragma unroll 8
    for (int a = 0; a < 128; ++a) {
        const float vv = (a < 127) ? P.cache_v()[((size_t)(b * 128 + a + 1) * 2 + kvh) * 64 + lane] : P.nvs()[((size_t)(b * 128 + 127) * 2 + kvh) * 64 + lane];
        if (a < 127) P.nvs()[((size_t)(b * 128 + a) * 2 + kvh) * 64 + lane] = vv;
#pragma unroll
        for (int hh = 0; hh < 4; ++hh) o[hh] += ps[hh * 128 + a] * vv;
    }
#pragma unroll
    for (int hh = 0; hh < 4; ++hh) MIX[row * DM + (4 * kvh + hh) * 64 + lane] = f2bf(o[hh] * linv[hh]);
}
__device__ __forceinline__ void attn_sample_block(const Args& P, LAS unsigned char* lds, int b, int kvh) {
    const int tid = threadIdx.x, lane = tid & 63, w = __builtin_amdgcn_readfirstlane(tid >> 6);
    unsigned char* ws = P.ws();
    const bf16_t* Q = (const bf16_t*)(ws + WS_B + B_Q0); bf16_t* MIX = (bf16_t*)(ws + WS_A); const float* B2g = (const float*)(ws + WS_BIAS2);
    LAS float* qs = (LAS float*)lds;
    LAS float* SC = qs + 256;
    LAS float* OP = SC + 512;
    const size_t row = (size_t)MP + b;
    if (tid < 256) qs[tid] = bf2f(Q[row * 512 + (4 * kvh + (tid >> 6)) * 64 + (tid & 63)]);
    __syncthreads();
    {
        const int a = 16 * w + (lane >> 2), qd = lane & 3;
        const float* kp = ((a < 127) ? P.cache_k() + ((size_t)(b * 128 + a + 1) * 2 + kvh) * 64 : P.nks() + ((size_t)(b * 128 + 127) * 2 + kvh) * 64) + 16 * qd;
        f32x4 k4[4];
#pragma unroll
        for (int c = 0; c < 4; ++c) k4[c] = *(const f32x4*)(kp + 4 * c);
        if (a < 127) { float* ko = P.nks() + ((size_t)(b * 128 + a) * 2 + kvh) * 64 + 16 * qd;
#pragma unroll
            for (int c = 0; c < 4; ++c) *(f32x4*)(ko + 4 * c) = k4[c]; }
        float dsum[4];
#pragma unroll
        for (int hh = 0; hh < 4; ++hh) {
            float dd = 0.f;
#pragma unroll
            for (int c = 0; c < 4; ++c) { const f32x4 q4 = *(const LAS f32x4*)(qs + hh * 64 + 16 * qd + 4 * c); dd += (q4[0] * k4[c][0] + q4[1] * k4[c][1]) + (q4[2] * k4[c][2] + q4[3] * k4[c][3]); }
            dd += __shfl_xor(dd, 1); dd += __shfl_xor(dd, 2);
            dsum[hh] = dd;
        }
        if (qd == 0) {
#pragma unroll
            for (int hh = 0; hh < 4; ++hh) SC[hh * 128 + a] = dsum[hh] + B2g[(4 * kvh + hh) * 128 + (127 - a)];
        }
    }
    __syncthreads();
    if (w < 4) {
        const float sk2 = P.attn_sink()[4 * kvh + w] * LOG2E;
        const float s0 = SC[w * 128 + lane], s1 = SC[w * 128 + 64 + lane];
        const float mx = fmaxf(wmax(fmaxf(s0, s1)), sk2);
        const float p0 = ex2(s0 - mx), p1 = ex2(s1 - mx);
        const float inv = 1.f / (wsum(p0 + p1) + ex2(sk2 - mx));
        SC[w * 128 + lane] = p0 * inv; SC[w * 128 + 64 + lane] = p1 * inv;
    }
    __syncthreads();
    {
        float o[4] = {0.f, 0.f, 0.f, 0.f};
        float vv[16];
#pragma unroll
        for (int i = 0; i < 16; ++i) {
            const int a = 16 * w + i;
            vv[i] = (a < 127) ? P.cache_v()[((size_t)(b * 128 + a + 1) * 2 + kvh) * 64 + lane] : P.nvs()[((size_t)(b * 128 + 127) * 2 + kvh) * 64 + lane];
        }
#pragma unroll
        for (int i = 0; i < 16; ++i) {
            const int a = 16 * w + i;
            if (a < 127) P.nvs()[((size_t)(b * 128 + a) * 2 + kvh) * 64 + lane] = vv[i];
#pragma unroll
            for (int hh = 0; hh < 4; ++hh) o[hh] += SC[hh * 128 + a] * vv[i];
        }
#pragma unroll
        for (int hh = 0; hh < 4; ++hh) OP[(w * 4 + hh) * 64 + lane] = o[hh];
    }
    __syncthreads();
    if (tid < 256) {
        float o = 0.f;
#pragma unroll
        for (int ww = 0; ww < 8; ++ww) o += OP[(ww * 4 + (tid >> 6)) * 64 + (tid & 63)];
        MIX[row * DM + (4 * kvh + (tid >> 6)) * 64 + (tid & 63)] = f2bf(o);
    }
    __syncthreads();
}
__device__ __forceinline__ void gmlp_sample_wave(const Args& P, int b) {
    const int lane = threadIdx.x & 63;
    unsigned char* ws = P.ws();
    const bf16_t* U = (const bf16_t*)(ws + WS_B + B_U0); const bf16_t* GV = (const bf16_t*)(ws + WS_B + B_GV0);
    const float* LNS = (const float*)(ws + WS_LNS); bf16_t* MIX = (bf16_t*)(ws + WS_A);
    const size_t row = (size_t)MP + b;
    float s1 = 0.f, s2 = 0.f;
#pragma unroll
    for (int q = 0; q < 8; ++q) { s1 += LNS[row * 16 + 2 * q]; s2 += LNS[row * 16 + 2 * q + 1]; }
    const float mean = s1 * (1.f / 512.f), rstd = rsqrtf(fmaxf(s2 * (1.f / 512.f) - mean * mean, 0.f) + EPS);
    const int c = lane * 8, grp = c >> 6;
    const u32x4 gw = *(const u32x4*)(GV + row * 512 + c), uw = *(const u32x4*)(U + row * 512 + c);
    const float g8[8] = {bflo(gw.x), bfhi(gw.x), bflo(gw.y), bfhi(gw.y), bflo(gw.z), bfhi(gw.z), bflo(gw.w), bfhi(gw.w)};
    const float u8[8] = {bflo(uw.x), bfhi(uw.x), bflo(uw.y), bfhi(uw.y), bflo(uw.z), bfhi(uw.z), bflo(uw.w), bfhi(uw.w)};
    const float w00 = P.gmlp_w_s()[(size_t)grp * 128 * 128], bs0 = P.gmlp_b_s()[grp * 128];
    f32x4 v0, v1, o0, o1;
#pragma unroll
    for (int e = 0; e < 4; ++e) {
        v0[e] = (g8[e] - mean) * rstd * P.gmlp_ln_g()[c + e] + P.gmlp_ln_b()[c + e];
        v1[e] = (g8[4 + e] - mean) * rstd * P.gmlp_ln_g()[c + 4 + e] + P.gmlp_ln_b()[c + 4 + e];
        o0[e] = u8[e] * (w00 * v0[e] + bs0); o1[e] = u8[4 + e] * (w00 * v1[e] + bs0);
    }
    *(f32x4*)(P.gvs() + (size_t)b * 512 + c) = v0; *(f32x4*)(P.gvs() + (size_t)b * 512 + c + 4) = v1;
    *(u32x4*)(MIX + row * DM + 512 + c) = pack8(o0, o1);
}

__device__ __forceinline__ void hgrn_scan_a(const Args& P, LAS unsigned char* lds, int b, int h, int seg) {
    const int tid = threadIdx.x, lane = tid & 63, w = __builtin_amdgcn_readfirstlane(tid >> 6), li = lane & 15, gq = lane >> 4;
    unsigned char* ws = P.ws();
    const bf16_t* K1 = (const bf16_t*)(ws + WS_B + A_BYTES); const bf16_t* I1 = (const bf16_t*)(ws + WS_B + 2 * A_BYTES); const unsigned short* F1 = (const unsigned short*)(ws + WS_B + 4 * A_BYTES);
    float* SLOC = (float*)(ws + WS_SLOC); float* ATOT = (float*)(ws + WS_ATOT);
    LAS bf16_t* KHT = (LAS bf16_t*)lds; LAS bf16_t* VT = (LAS bf16_t*)(lds + 34816); LAS float* TOT = (LAS float*)(lds + 69632);
    const int dp = lane, rg = w;
    const int unit = (b * 8 + h) * NSEG + seg;
    const size_t rowseg = (size_t)b * SEQ + (size_t)seg * SEGLEN;
    const size_t col2 = (size_t)h * 128 + 2 * dp;
    f32x4 Sacc[8];
#pragma unroll
    for (int db = 0; db < 8; ++db) Sacc[db] = (f32x4){0.f, 0.f, 0.f, 0.f};
    float C0 = 1.f, C1 = 1.f;
    constexpr int NSB = SEGLEN / 128;
    unsigned fr[16], ir[16];
#pragma unroll
    for (int j = 0; j < 16; ++j) { const size_t off = (rowseg + (size_t)(NSB - 1) * 128 + 16 * rg + j) * DM + col2; fr[j] = *(const unsigned*)(F1 + off); ir[j] = *(const unsigned*)(I1 + off); }
    for (int sb = NSB - 1; sb >= 0; --sb) {
        float e0[16], e1[16], k0f[16], k1f[16]; unsigned vv[16];
        { float p0 = 1.f, p1 = 1.f;
#pragma unroll
          for (int j = 15; j >= 0; --j) { const float f0 = h2f((unsigned short)(fr[j] & 0xffffu)), f1 = h2f((unsigned short)(fr[j] >> 16)); e0[j] = p0; e1[j] = p1; p0 *= f0; p1 *= f1; k0f[j] = 1.f - f0; k1f[j] = 1.f - f1; vv[j] = ir[j]; }
          *(LAS f32x2*)(TOT + rg * 128 + 2 * dp) = (f32x2){p0, p1}; }
        { const int nsb = sb > 0 ? sb - 1 : sb;
#pragma unroll
          for (int j = 0; j < 16; ++j) { const size_t off = (rowseg + (size_t)nsb * 128 + 16 * rg + j) * DM + col2; fr[j] = *(const unsigned*)(F1 + off); ir[j] = *(const unsigned*)(I1 + off); } }
        __syncthreads();
        float g0 = C0, g1 = C1, t0 = 1.f, t1 = 1.f;
#pragma unroll
        for (int r2 = 0; r2 < 8; ++r2) { const f32x2 tt = *(const LAS f32x2*)(TOT + r2 * 128 + 2 * dp); t0 *= tt.x; t1 *= tt.y; if (r2 > rg) { g0 *= tt.x; g1 *= tt.y; } }
        {
            unsigned k0w[8], k1w[8], v0w[8], v1w[8];
#pragma unroll
            for (int jj = 0; jj < 8; ++jj) {
                const int ja = 2 * jj, jb = 2 * jj + 1;
                k0w[jj] = cvt_pk_bf16(k0f[ja] * (e0[ja] * g0), k0f[jb] * (e0[jb] * g0));
                k1w[jj] = cvt_pk_bf16(k1f[ja] * (e1[ja] * g1), k1f[jb] * (e1[jb] * g1));
                v0w[jj] = (vv[ja] & 0xffffu) | (vv[jb] << 16);
                v1w[jj] = (vv[ja] >> 16) | (vv[jb] & 0xffff0000u);
            }
            LAS u32x4* kp0 = (LAS u32x4*)(KHT + (2 * dp) * 136 + 16 * rg); LAS u32x4* kp1 = (LAS u32x4*)(KHT + (2 * dp + 1) * 136 + 16 * rg);
            LAS u32x4* vp0 = (LAS u32x4*)(VT + (2 * dp) * 136 + 16 * rg); LAS u32x4* vp1 = (LAS u32x4*)(VT + (2 * dp + 1) * 136 + 16 * rg);
            kp0[0] = (u32x4){k0w[0], k0w[1], k0w[2], k0w[3]}; kp0[1] = (u32x4){k0w[4], k0w[5], k0w[6], k0w[7]};
            kp1[0] = (u32x4){k1w[0], k1w[1], k1w[2], k1w[3]}; kp1[1] = (u32x4){k1w[4], k1w[5], k1w[6], k1w[7]};
            vp0[0] = (u32x4){v0w[0], v0w[1], v0w[2], v0w[3]}; vp0[1] = (u32x4){v0w[4], v0w[5], v0w[6], v0w[7]};
            vp1[0] = (u32x4){v1w[0], v1w[1], v1w[2], v1w[3]}; vp1[1] = (u32x4){v1w[4], v1w[5], v1w[6], v1w[7]};
        }
        C0 *= t0; C1 *= t1;
        __syncthreads();
#pragma unroll
        for (int ks = 0; ks < 4; ++ks) {
            const bf16x8 bb = *(const LAS bf16x8*)(VT + (16 * w + li) * 136 + 32 * ks + 8 * gq);
#pragma unroll
            for (int db = 0; db < 8; ++db) {
                const bf16x8 a = *(const LAS bf16x8*)(KHT + (16 * db + li) * 136 + 32 * ks + 8 * gq);
                Sacc[db] = mfma16(a, bb, Sacc[db]);
            }
        }
        __syncthreads();
    }
    float* sl = SLOC + (size_t)unit * 16384;
#pragma unroll
    for (int db = 0; db < 8; ++db)
#pragma unroll
        for (int r = 0; r < 4; ++r) sl[((w * 8 + db) * 4 + r) * 64 + lane] = Sacc[db][r];
    if (rg == 0) *(f32x2*)(ATOT + (size_t)unit * 128 + 2 * dp) = (f32x2){C0, C1};
}

template <int MODE = 0>
__device__ __forceinline__ void hgrn_scan_b(const Args& P, LAS unsigned char* lds, int b, int h, int seg) {
    const int tid = threadIdx.x, lane = tid & 63, w = __builtin_amdgcn_readfirstlane(tid >> 6), li = lane & 15, gq = lane >> 4;
    unsigned char* ws = P.ws();
    const bf16_t* Q1 = (const bf16_t*)(ws + WS_B); const bf16_t* K1 = (const bf16_t*)(ws + WS_B + A_BYTES); const bf16_t* I1 = (const bf16_t*)(ws + WS_B + 2 * A_BYTES);
    const bf16_t* SG1 = (const bf16_t*)(ws + WS_B + 3 * A_BYTES); const unsigned short* F1 = (const unsigned short*)(ws + WS_B + 4 * A_BYTES);
    bf16_t* MIX = (bf16_t*)(ws + WS_A);
    const float* SLOC = (const float*)(ws + WS_SLOC); const float* ATOT = (const float*)(ws + WS_ATOT);
    LAS bf16_t* QT = (LAS bf16_t*)lds; LAS bf16_t* KT = (LAS bf16_t*)(lds + 8704); LAS bf16_t* KHT = (LAS bf16_t*)(lds + 17408); LAS bf16_t* VT = (LAS bf16_t*)(lds + 27648);
    LAS bf16_t* ATT = (LAS bf16_t*)(lds + 37888); LAS bf16_t* ST = (LAS bf16_t*)(lds + 40448);
    LAS float* AC = (LAS float*)(lds + 75264); LAS float* TOT = (LAS float*)(lds + 75776); LAS float* OT = (LAS float*)(lds + 79872);
    const int dp = lane, rg = w;
    f32x4 Sacc[8];
#pragma unroll
    for (int db = 0; db < 8; ++db) Sacc[db] = (f32x4){0.f, 0.f, 0.f, 0.f};
    for (int i = 0; i < (MODE == 1 ? 0 : seg); ++i) {
        const int ui = (b * 8 + h) * NSEG + i;
        const float* sl = SLOC + (size_t)ui * 16384; const float* at = ATOT + (size_t)ui * 128;
#pragma unroll
        for (int db = 0; db < 8; ++db) {
            const f32x4 a4 = *(const f32x4*)(at + 16 * db + 4 * gq);
#pragma unroll
            for (int r = 0; r < 4; ++r) Sacc[db][r] = Sacc[db][r] * a4[r] + sl[((w * 8 + db) * 4 + r) * 64 + lane];
        }
    }
#pragma unroll
    for (int db = 0; db < 8; ++db) *(LAS u32x2*)(ST + (16 * w + li) * 136 + 16 * db + 4 * gq) = pack4(Sacc[db]);
    const size_t rowseg = (size_t)b * SEQ + (size_t)seg * SEGLEN;
    const size_t col2 = (size_t)h * 128 + 2 * dp;
    constexpr int NCH = (MODE == 2) ? 1 : SEGLEN / CH;
    const int ot = tid >> 4, oe = (tid & 15) * 8;
    const f32x4 wn0 = *(const f32x4*)(P.c_out_norm() + oe), wn1 = *(const f32x4*)(P.c_out_norm() + oe + 4);
    unsigned fr[4], qr[4], ir[4]; u32x4 sgr;
    unsigned fr2[4], qr2[4], ir2[4]; u32x4 sgr2;
#pragma unroll
    for (int j = 0; j < 4; ++j) { const size_t off = (rowseg + 4 * rg + j) * DM + col2; fr[j] = *(const unsigned*)(F1 + off); ir[j] = *(const unsigned*)(I1 + off); qr[j] = *(const unsigned*)(Q1 + off); }
    sgr = *(const u32x4*)(SG1 + (rowseg + ot) * DM + h * 128 + oe);
#pragma unroll
    for (int j = 0; j < 4; ++j) { const size_t off = (rowseg + CH + 4 * rg + j) * DM + col2; fr2[j] = *(const unsigned*)(F1 + off); ir2[j] = *(const unsigned*)(I1 + off); qr2[j] = *(const unsigned*)(Q1 + off); }
    sgr2 = *(const u32x4*)(SG1 + (rowseg + CH + ot) * DM + h * 128 + oe);
    for (int c = 0; c < NCH; ++c) {
        const size_t row0 = rowseg + (size_t)c * CH;
        float a0[4], a1[4], k0f[4], k1f[4]; unsigned qq[4], vv[4];
        { float p0 = 1.f, p1 = 1.f;
#pragma unroll
          for (int j = 0; j < 4; ++j) { const float f0 = h2f((unsigned short)(fr[j] & 0xffffu)), f1 = h2f((unsigned short)(fr[j] >> 16)); p0 *= f0; p1 *= f1; a0[j] = p0; a1[j] = p1; k0f[j] = 1.f - f0; k1f[j] = 1.f - f1; qq[j] = qr[j]; vv[j] = ir[j]; }
          *(LAS f32x2*)(TOT + rg * 128 + 2 * dp) = (f32x2){p0, p1}; }
        const u32x4 sgc = sgr;
        { const size_t nrow = row0 + ((c + 2 < NCH) ? 2 * CH : 0);
#pragma unroll
          for (int j = 0; j < 4; ++j) { fr[j] = fr2[j]; ir[j] = ir2[j]; qr[j] = qr2[j]; }
          sgr = sgr2;
#pragma unroll
          for (int j = 0; j < 4; ++j) { const size_t off = (nrow + 4 * rg + j) * DM + col2; fr2[j] = *(const unsigned*)(F1 + off); ir2[j] = *(const unsigned*)(I1 + off); qr2[j] = *(const unsigned*)(Q1 + off); }
          sgr2 = *(const u32x4*)(SG1 + (nrow + ot) * DM + h * 128 + oe); }
        __syncthreads();
        float g0 = 1.f, g1 = 1.f, t0 = 1.f, t1 = 1.f;
#pragma unroll
        for (int r2 = 0; r2 < 8; ++r2) { const f32x2 tt = *(const LAS f32x2*)(TOT + r2 * 128 + 2 * dp); t0 *= tt.x; t1 *= tt.y; if (r2 < rg) { g0 *= tt.x; g1 *= tt.y; } }
        {
            unsigned kh0[2], kh1[2], v0w[2], v1w[2];
            float kh0f[4], kh1f[4];
#pragma unroll
            for (int j = 0; j < 4; ++j) {
                const float A0 = a0[j] * g0, A1 = a1[j] * g1, r0 = __builtin_amdgcn_rcpf(A0), r1 = __builtin_amdgcn_rcpf(A1);
                const float kt0 = k0f[j] * r0, kt1 = k1f[j] * r1;
                const int t = 4 * rg + j;
                *(LAS unsigned*)(QT + t * 136 + 2 * dp) = cvt_pk_bf16(bflo(qq[j]) * A0, bfhi(qq[j]) * A1);
                *(LAS unsigned*)(KT + t * 136 + 2 * dp) = cvt_pk_bf16(kt0, kt1);
                kh0f[j] = kt0 * t0; kh1f[j] = kt1 * t1;
            }
            kh0[0] = cvt_pk_bf16(kh0f[0], kh0f[1]); kh0[1] = cvt_pk_bf16(kh0f[2], kh0f[3]);
            kh1[0] = cvt_pk_bf16(kh1f[0], kh1f[1]); kh1[1] = cvt_pk_bf16(kh1f[2], kh1f[3]);
            v0w[0] = (vv[0] & 0xffffu) | (vv[1] << 16); v0w[1] = (vv[2] & 0xffffu) | (vv[3] << 16);
            v1w[0] = (vv[0] >> 16) | (vv[1] & 0xffff0000u); v1w[1] = (vv[2] >> 16) | (vv[3] & 0xffff0000u);
            *(LAS u32x2*)(KHT + (2 * dp) * 40 + 4 * rg) = (u32x2){kh0[0], kh0[1]}; *(LAS u32x2*)(KHT + (2 * dp + 1) * 40 + 4 * rg) = (u32x2){kh1[0], kh1[1]};
            *(LAS u32x2*)(VT + (2 * dp) * 40 + 4 * rg) = (u32x2){v0w[0], v0w[1]}; *(LAS u32x2*)(VT + (2 * dp + 1) * 40 + 4 * rg) = (u32x2){v1w[0], v1w[1]};
            if (rg == 0) *(LAS f32x2*)(AC + 2 * dp) = (f32x2){t0, t1};
        }
        __syncthreads();
        f32x4 O[2];
#pragma unroll
        for (int tb = 0; tb < 2; ++tb) {
            O[tb] = (f32x4){0.f, 0.f, 0.f, 0.f};
#pragma unroll
            for (int ks = 0; ks < 4; ++ks) {
                const bf16x8 a = *(const LAS bf16x8*)(QT + (16 * tb + li) * 136 + 32 * ks + 8 * gq);
                const bf16x8 bb = *(const LAS bf16x8*)(ST + (16 * w + li) * 136 + 32 * ks + 8 * gq);
                O[tb] = mfma16(a, bb, O[tb]);
            }
        }
        if (w < 4) {
            const int tb = w >> 1, sb = w & 1;
            f32x4 at = (f32x4){0.f, 0.f, 0.f, 0.f};
            if (!(tb == 0 && sb == 1)) {
#pragma unroll
                for (int ks = 0; ks < 4; ++ks) {
                    const bf16x8 a = *(const LAS bf16x8*)(QT + (16 * tb + li) * 136 + 32 * ks + 8 * gq);
                    const bf16x8 bb = *(const LAS bf16x8*)(KT + (16 * sb + li) * 136 + 32 * ks + 8 * gq);
                    at = mfma16(a, bb, at);
                }
            }
#pragma unroll
            for (int r = 0; r < 4; ++r) {
                const int t = 16 * tb + 4 * gq + r, s = 16 * sb + li;
                ATT[t * 40 + s] = (s <= t) ? f2bf(at[r]) : (bf16_t)0;
            }
        }
#pragma unroll
        for (int db = 0; db < 8; ++db) {
            const bf16x8 a = *(const LAS bf16x8*)(KHT + (16 * db + li) * 40 + 8 * gq);
            const bf16x8 bb = *(const LAS bf16x8*)(VT + (16 * w + li) * 40 + 8 * gq);
            const f32x4 a4 = *(const LAS f32x4*)(AC + 16 * db + 4 * gq);
            Sacc[db] = mfma16(a, bb, Sacc[db] * a4);
            *(LAS u32x2*)(ST + (16 * w + li) * 136 + 16 * db + 4 * gq) = pack4(Sacc[db]);
        }
        __syncthreads();
#pragma unroll
        for (int tb = 0; tb < 2; ++tb) {
            const bf16x8 a = *(const LAS bf16x8*)(ATT + (16 * tb + li) * 40 + 8 * gq);
            const bf16x8 bb = *(const LAS bf16x8*)(VT + (16 * w + li) * 40 + 8 * gq);
            O[tb] = mfma16(a, bb, O[tb]);
#pragma unroll
            for (int r = 0; r < 4; ++r) OT[(16 * tb + 4 * gq + r) * 132 + 16 * w + li] = O[tb][r];
        }
        __syncthreads();
        {
            const f32x4 o0 = *(const LAS f32x4*)(OT + ot * 132 + oe), o1 = *(const LAS f32x4*)(OT + ot * 132 + oe + 4);
            float ss = sumsq4(o0) + sumsq4(o1);
            ss += __shfl_xor(ss, 1); ss += __shfl_xor(ss, 2); ss += __shfl_xor(ss, 4); ss += __shfl_xor(ss, 8);
            const float rinv = rsqrtf(ss * (1.f / 128.f) + EPS);
            const f32x4 s0 = (f32x4){bflo(sgc.x), bfhi(sgc.x), bflo(sgc.y), bfhi(sgc.y)}, s1 = (f32x4){bflo(sgc.z), bfhi(sgc.z), bflo(sgc.w), bfhi(sgc.w)};
            *(u32x4*)(MIX + (row0 + ot) * DM + h * 128 + oe) = pack8(o0 * wn0 * s0 * rinv, o1 * wn1 * s1 * rinv);
        }
    }
    if (seg == NSEG - 1) {
        float* so = P.stp() + (size_t)(b * 8 + h) * 16384;
#pragma unroll
        for (int db = 0; db < 8; ++db)
#pragma unroll
            for (int r = 0; r < 4; ++r) so[(size_t)(16 * db + 4 * gq + r) * 128 + 16 * w + li] = Sacc[db][r];
    }
    __syncthreads();
}

__device__ __forceinline__ void hgrn_sample_unit(const Args& P, LAS unsigned char* lds, int b, int h) {
    const int tid = threadIdx.x, lane = tid & 63;
    unsigned char* ws = P.ws();
    const bf16_t* Q1 = (const bf16_t*)(ws + WS_B); const bf16_t* K1 = (const bf16_t*)(ws + WS_B + A_BYTES); const bf16_t* I1 = (const bf16_t*)(ws + WS_B + 2 * A_BYTES);
    const bf16_t* SG1 = (const bf16_t*)(ws + WS_B + 3 * A_BYTES); const unsigned short* LF = (const unsigned short*)(ws + WS_B + 4 * A_BYTES);
    bf16_t* MIX = (bf16_t*)(ws + WS_A);
    LAS float* fv = (LAS float*)(lds + 81920); LAS float* kv = fv + 128; LAS float* qv = kv + 128; LAS float* iv = qv + 128; LAS float* OP = iv + 128; LAS float* RS = OP + 2048;
    const size_t row = (size_t)MP + b;
    if (tid < 128) {
        const size_t off = row * DM + h * 128 + tid;
        fv[tid] = h2f(LF[off]); kv[tid] = 1.f - fv[tid]; qv[tid] = bf2f(Q1[off]); iv[tid] = bf2f(I1[off]);
    }
    __syncthreads();
    const int e4 = tid & 31, dg = tid >> 5;
    const float* s0 = P.state_hgrn() + (size_t)(b * 8 + h) * 16384; float* so = P.sts() + (size_t)(b * 8 + h) * 16384;
    const f32x4 i4 = *(const LAS f32x4*)(iv + 4 * e4);
    f32x4 o4 = (f32x4){0.f, 0.f, 0.f, 0.f};
#pragma unroll
    for (int dd = 0; dd < 8; ++dd) {
        const int dq = 8 * dg + dd;
        const f32x4 sv = *(const f32x4*)(s0 + (size_t)dq * 128 + 4 * e4);
        const f32x4 sn = sv * fv[dq] + i4 * kv[dq];
        *(f32x4*)(so + (size_t)dq * 128 + 4 * e4) = sn;
        o4 += sn * qv[dq];
    }
    *(LAS f32x4*)(OP + dg * 128 + 4 * e4) = o4;
    __syncthreads();
    float o = 0.f;
    if (tid < 128) {
#pragma unroll
        for (int g = 0; g < 16; ++g) o += OP[g * 128 + tid];
        const float s = wsum(o * o);
        if (lane == 0) RS[tid >> 6] = s;
    }
    __syncthreads();
    if (tid < 128) {
        const float rinv = rsqrtf((RS[0] + RS[1]) * (1.f / 128.f) + EPS);
        const size_t off = row * DM + h * 128 + tid;
        MIX[off] = f2bf(o * rinv * P.c_out_norm()[tid] * bf2f(SG1[off]));
    }
    __syncthreads();
}


template <int K, int NB>
__device__ __forceinline__ void thin_unit(LAS unsigned char* lds, const bf16_t* A  , const bf16_t* Bt, int rg, int cg, f32x4 (&out)[NB]) {
    const int tid = threadIdx.x, lane = tid & 63, w = __builtin_amdgcn_readfirstlane(tid >> 6), li = lane & 15, gq = lane >> 4;
    constexpr int KW = K / 8, NKS = KW / 32;
    const bf16_t* ap = A + (size_t)(16 * rg + li) * K + w * KW + 8 * gq;
    const bf16_t* bp = Bt + (size_t)(16 * NB * cg + li) * K + w * KW + 8 * gq;
    f32x4 acc[NB];
#pragma unroll
    for (int nb = 0; nb < NB; ++nb) acc[nb] = (f32x4){0.f, 0.f, 0.f, 0.f};
#pragma unroll
    for (int ks = 0; ks < NKS; ++ks) {
        const bf16x8 af = *(const bf16x8*)(ap + 32 * ks);
#pragma unroll
        for (int nb = 0; nb < NB; ++nb) {
            const bf16x8 bf = *(const bf16x8*)(bp + (size_t)(16 * nb) * K + 32 * ks);
            acc[nb] = mfma16(bf, af, acc[nb]);
        }
    }
    LAS f32x4* PART = (LAS f32x4*)lds;
#pragma unroll
    for (int nb = 0; nb < NB; ++nb) PART[(w * NB + nb) * 64 + lane] = acc[nb];
    __syncthreads();
    if (w == 0) {
#pragma unroll
        for (int nb = 0; nb < NB; ++nb) {
            f32x4 s = PART[nb * 64 + lane];
#pragma unroll
            for (int p = 1; p < 8; ++p) s += PART[(p * NB + nb) * 64 + lane];
            out[nb] = s;
        }
    }
    __syncthreads();
}
template <int MODE>
__device__ __forceinline__ void thin_epi_res(const f32x4 (&o)[2], int rg, int cg, const float* xin_s, const bf16_t* RB_, bf16_t* OB, float* OF, float* SS) {
    const int lane = threadIdx.x & 63, li = lane & 15, gq = lane >> 4;
    const int row = MP + 16 * rg + li;
    const int c0 = 32 * cg + 8 * gq;
    f32x4 p0, p1;
    if (MODE == 0) { const float* sp = xin_s + (size_t)(16 * rg + li) * DM + c0; p0 = *(const f32x4*)sp; p1 = *(const f32x4*)(sp + 4); }
    else { const u32x4 w = *(const u32x4*)(RB_ + (size_t)row * DM + c0); p0 = (f32x4){bflo(w.x), bfhi(w.x), bflo(w.y), bfhi(w.y)}; p1 = (f32x4){bflo(w.z), bfhi(w.z), bflo(w.w), bfhi(w.w)}; }
    const f32x4 o0 = p0 + o[0], o1 = p1 + o[1];
    if (MODE == 2) { *(f32x4*)(OF + (size_t)row * DM + c0) = o0; *(f32x4*)(OF + (size_t)row * DM + c0 + 4) = o1; }
    else {
        *(u32x4*)(OB + (size_t)row * DM + c0) = pack8(o0, o1);
        float ss = sumsq4(o0) + sumsq4(o1);
        ss += __shfl_xor(ss, 16); ss += __shfl_xor(ss, 32);
        if (gq == 0) SS[(size_t)row * 32 + cg] = ss;
    }
}
__device__ __forceinline__ void thin_epi_inc(const f32x4 (&o)[4], int rg, int cg, const float* SS, const float* LBT, bf16_t* Q1, bf16_t* K1, bf16_t* I1, bf16_t* SG1, unsigned short* LF) {
    const int lane = threadIdx.x & 63, li = lane & 15, gq = lane >> 4;
    const int row = MP + 16 * rg + li;
    const float rinv = row_rinv(SS, row);
#pragma unroll
    for (int h = 0; h < 2; ++h) {
        const int col = 64 * cg + 32 * h + 8 * gq, type = col >> 10, c0 = col & 1023;
        const f32x4 v0 = o[2 * h] * rinv, v1 = o[2 * h + 1] * rinv;
        const size_t off = (size_t)row * DM + c0;
        if (type == 0) *(u32x4*)(Q1 + off) = pack8(v0, v1);
        else if (type == 2) *(u32x4*)(I1 + off) = pack8(v0, v1);
        else if (type == 3) {
            f32x4 s0, s1;
#pragma unroll
            for (int e = 0; e < 4; ++e) { s0[e] = sigm(v0[e]); s1[e] = sigm(v1[e]); }
            *(u32x4*)(SG1 + off) = pack8(s0, s1);
        } else {
            const f32x4 l0 = *(const f32x4*)(LBT + c0), l1 = *(const f32x4*)(LBT + c0 + 4);
            float lf[8];
#pragma unroll
            for (int e = 0; e < 4; ++e) {
                const float f0 = l0[e] + (1.f - l0[e]) * sigm(v0[e]), f1 = l1[e] + (1.f - l1[e]) * sigm(v1[e]);
                lf[e] = f0; lf[4 + e] = f1;
            }
            u32x4 lw;
            lw.x = (unsigned)f2h(lf[0]) | ((unsigned)f2h(lf[1]) << 16); lw.y = (unsigned)f2h(lf[2]) | ((unsigned)f2h(lf[3]) << 16);
            lw.z = (unsigned)f2h(lf[4]) | ((unsigned)f2h(lf[5]) << 16); lw.w = (unsigned)f2h(lf[6]) | ((unsigned)f2h(lf[7]) << 16);
            *(u32x4*)(LF + off) = lw;
        }
    }
}

constexpr int NPH = 12;
__global__ void __launch_bounds__(512, 2) fwd_kernel(Args args) {
    extern __shared__ __attribute__((aligned(16))) unsigned char lds_raw[];
    LAS unsigned char* lds = (LAS unsigned char*)lds_raw;
    const int tid = threadIdx.x, blk = blockIdx.x, G = gridDim.x;
    const int wv = __builtin_amdgcn_readfirstlane(tid >> 6);
    const Args& P = args;
    unsigned char* ws = args.ws_;
    volatile LAS unsigned* MISC = (volatile LAS unsigned*)(lds + MISC_OFF);
    for (int u = tid; u < (LDS_BYTES - RING_BYTES) / 4; u += 512) ((LAS unsigned*)(lds + RING_BYTES))[u] = 0u;
    __syncthreads();
    const int lo = args.ph_lo, hi = args.ph_hi;
    const bool multi = (hi - lo) > 1;
    XcdBarrier bar; bar.bar = (unsigned*)(ws + WS_CTL) + CW_BAR; bar.x = 0; bar.st = nullptr;
    if (multi) bar = xcd_barrier_post((unsigned*)(ws + WS_CTL) + CW_BAR, MISC + 8);
#ifndef PHASE_MASK
#define PHASE_MASK 0xFFF
#endif
#define IN(k) ((((PHASE_MASK) >> (k)) & 1) && lo <= (k) && (k) < hi)
#define SEAM(k) do { if (IN(k) && IN((k) + 1) && rep_ == ((((REPEAT_MASK) >> (k)) & 1) ? 1 : 0)) xcd_barrier(bar); } while (0)
#ifndef REPEAT_MASK
#define REPEAT_MASK 0
#endif
#define REP(k) for (int rep_ = 0; rep_ < ((((REPEAT_MASK) >> (k)) & 1) ? 2 : 1); ++rep_)
    float* SS = (float*)(ws + WS_SS);
    bf16_t* RA = (bf16_t*)(ws + WS_A); bf16_t* RB = (bf16_t*)(ws + WS_B);

    if (IN(0)) REP(0) { p0_prologue(P, lds); SEAM(0);
#ifdef XBAR_EXTRA
        for (int i_ = 0; i_ < XBAR_EXTRA; ++i_) xcd_barrier(bar);
#endif
    }
    if (IN(1)) REP(1) {
        Gemm g{(const bf16_t*)P.X(), (const bf16_t*)(ws + WS_W_INAB), MPAD, N_INAB, DM}; StaticOrder S; S.init(MPAD, N_INAB, G, blk);
        EpiInAb E{SS, (bf16_t*)(ws + WS_B + B_Q0), (bf16_t*)(ws + WS_B + B_K0), (bf16_t*)(ws + WS_B + B_V0), (bf16_t*)(ws + WS_B + B_U0), (bf16_t*)(ws + WS_B + B_GV0),
                  (float*)(ws + WS_LNS), P.q_norm(), P.k_norm(), P.nkp(), P.nvp(), P.nks(), P.nvs()};
        gemm_phase<EpiInAb, true>(lds, g, S, E);
        wconv_deferred(P, lds, 0, 455 - 256);
        SEAM(1);
    }
    if (IN(2)) REP(2) {
#ifndef P2_MASK
#define P2_MASK 15
#endif
#ifndef P2_DUP
#define P2_DUP 0
#endif
        if (P2_DUP & 1) { const int b = blk >> 6, qb = (blk >> 1) & 31, kvh = blk & 1; attn_prompt_unit(P, lds, b, qb, kvh); }
        if (P2_DUP & 2) { const int b = blk >> 6, chunk = (blk >> 1) & 31, gh = blk & 1; gmlp_unit(P, lds, b, chunk, gh); }
        if (P2_MASK & 1) { const int b = blk >> 6, qb = (blk >> 1) & 31, kvh = blk & 1; attn_prompt_unit(P, lds, b, qb, kvh); }
        if (P2_MASK & 2) { const int b = blk >> 6, chunk = (blk >> 1) & 31, gh = blk & 1; gmlp_unit(P, lds, b, chunk, gh); }
        if (P2_MASK & 4) attn_sample_block(P, lds, blk >> 1, blk & 1);
        if ((P2_MASK & 8) && wv == 1 && blk < 128) gmlp_sample_wave(P, blk);
        __syncthreads();
        SEAM(2);
    }
    if (IN(3)) REP(3) {
        { f32x4 to[2]; thin_unit<DM, 2>(lds, RA + (size_t)MP * DM, (const bf16_t*)(ws + WS_W_OUTAB), blk >> 5, blk & 31, to);
            if (wv == 0) thin_epi_res<1>(to, blk >> 5, blk & 31, nullptr, (const bf16_t*)P.X(), RB + B_XB / 2, nullptr, SS); }
        Gemm g{RA, (const bf16_t*)(ws + WS_W_OUTAB), MP, DM, DM}; StaticOrder S; S.init(MP, DM, G, blk);
        EpiRes<1> E{nullptr, nullptr, (const bf16_t*)P.X(), RB + B_XB / 2, nullptr, SS};
        gemm_phase<EpiRes<1>, true>(lds, g, S, E);
        SEAM(3);
    }
    if (IN(4)) REP(4) {
        Gemm g{RB + B_XB / 2, (const bf16_t*)(ws + WS_W_GU0), MPAD, N_GU, DM}; StaticOrder S; S.init(MPAD, N_GU, G, blk);
        EpiGU E{SS, RB + B_HID / 2};
        gemm_phase<EpiGU, true>(lds, g, S, E);
        wconv_deferred(P, lds, 1, 1430 - 5 * 256);
        SEAM(4);
    }
    if (IN(5)) REP(5) {
        bf16_t* RX = (bf16_t*)P.X();
        { f32x4 to[2]; thin_unit<FF, 2>(lds, RB + B_HID / 2 + (size_t)MP * FF, (const bf16_t*)(ws + WS_W_DN0), blk >> 5, blk & 31, to);
            if (wv == 0) thin_epi_res<1>(to, blk >> 5, blk & 31, nullptr, RB + B_XB / 2, RX, nullptr, SS); }
        Gemm g{RB + B_HID / 2, (const bf16_t*)(ws + WS_W_DN0), MP, DM, FF}; StaticOrder S; S.init(MP, DM, G, blk);
        EpiRes<1> E{nullptr, nullptr, RB + B_XB / 2, RX, nullptr, SS};
        gemm_phase<EpiRes<1>, true>(lds, g, S, E);
        SEAM(5);
    }
    if (IN(6)) REP(6) {
        const bf16_t* RX = (const bf16_t*)P.X();
        for (int tu = blk; tu < 512; tu += G) { f32x4 to[4]; thin_unit<DM, 4>(lds, RX + (size_t)MP * DM, (const bf16_t*)(ws + WS_W_INC), tu >> 6, tu & 63, to);
            if (wv == 0) thin_epi_inc(to, tu >> 6, tu & 63, SS, (const float*)(ws + WS_LBT), RB, RB + A_BYTES / 2, RB + 2 * (A_BYTES / 2), RB + 3 * (A_BYTES / 2), (unsigned short*)(RB + 4 * (A_BYTES / 2))); }
        Gemm g{RX, (const bf16_t*)(ws + WS_W_INC), MP, N_INC, DM}; StaticOrder S; S.init(MP, N_INC, G, blk);
        EpiInC E{SS, (const float*)(ws + WS_LBT), RB, RB + A_BYTES / 2, RB + 2 * (A_BYTES / 2), RB + 3 * (A_BYTES / 2), (unsigned short*)(RB + 4 * (A_BYTES / 2))};
#ifdef P6_DUP
        gemm_phase<EpiInC, true>(lds, g, S, E);
#endif
        gemm_phase<EpiInC, true>(lds, g, S, E);
        SEAM(6);
    }
    if (IN(7)) REP(7) {
#ifndef HG_DBG
#define HG_DBG 0
#endif
        if (!(HG_DBG & 2) && blk < 32 * NSEG) { const int bh = blk / NSEG, seg = blk % NSEG; if (seg < NSEG - 1) hgrn_scan_a(P, lds, bh >> 3, bh & 7, seg); }
        if (!(HG_DBG & 4)) for (int i = 0; i < 4; ++i) { const int su = blk * 4 + i; hgrn_sample_unit(P, lds, su >> 3, su & 7); }
        SEAM(7);
    }
    if (IN(8)) REP(8) {
#ifdef HG_PROBE
        if (blk < 32 * NSEG) { const int bh = blk / NSEG, seg = blk % NSEG; hgrn_scan_b<HG_PROBE>(P, lds, bh >> 3, bh & 7, seg); }
#endif
        if (!(HG_DBG & 1)) { if (blk < 32 * NSEG) { const int bh = blk / NSEG, seg = blk % NSEG; hgrn_scan_b<0>(P, lds, bh >> 3, bh & 7, seg); } }
        else { bf16_t* MIXz = (bf16_t*)(ws + WS_A); for (size_t i = (size_t)blk * 512 + tid; i < (size_t)MP * DM / 8; i += (size_t)G * 512) *(u32x4*)(MIXz + i * 8) = (u32x4){0u, 0u, 0u, 0u}; }
        SEAM(8);
    }
    if (IN(9)) REP(9) {
        const bf16_t* RX = (const bf16_t*)P.X();
        { f32x4 to[2]; thin_unit<DM, 2>(lds, RA + (size_t)MP * DM, (const bf16_t*)(ws + WS_W_OUTC), blk >> 5, blk & 31, to);
            if (wv == 0) thin_epi_res<1>(to, blk >> 5, blk & 31, nullptr, RX, RB + B_XB / 2, nullptr, SS); }
        Gemm g{RA, (const bf16_t*)(ws + WS_W_OUTC), MP, DM, DM}; StaticOrder S; S.init(MP, DM, G, blk);
        EpiRes<1> E{nullptr, nullptr, RX, RB + B_XB / 2, nullptr, SS};
        gemm_phase<EpiRes<1>, true>(lds, g, S, E);
        SEAM(9);
    }
    if (IN(10)) REP(10) {
        Gemm g{RB + B_XB / 2, (const bf16_t*)(ws + WS_W_GU1), MPAD, N_GU, DM}; StaticOrder S; S.init(MPAD, N_GU, G, blk);
        EpiGU E{SS, RB + B_HID / 2};
        gemm_phase<EpiGU, true>(lds, g, S, E);
        wconv_deferred(P, lds, 2, 1430 - 5 * 256);
        SEAM(10);
    }
    if (IN(11)) REP(11) {
        { f32x4 to[2]; thin_unit<FF, 2>(lds, RB + B_HID / 2 + (size_t)MP * FF, (const bf16_t*)(ws + WS_W_DN1), blk >> 5, blk & 31, to);
            if (wv == 0) thin_epi_res<2>(to, blk >> 5, blk & 31, nullptr, RB + B_XB / 2, nullptr, P.X(), nullptr); }
        Gemm g{RB + B_HID / 2, (const bf16_t*)(ws + WS_W_DN1), MP, DM, FF}; StaticOrder S; S.init(MP, DM, G, blk);
        EpiRes<2> E{nullptr, nullptr, RB + B_XB / 2, nullptr, P.X(), nullptr};
        gemm_phase<EpiRes<2>, true>(lds, g, S, E);
    }
#undef IN
#undef SEAM
}
}

#ifndef NAIVE_FROM
#define NAIVE_FROM 4
#endif
#ifndef N_LAUNCH_SPLIT
#define N_LAUNCH_SPLIT 0
#endif

#if NAIVE_FROM < 4
static void naive_tail(void* const* d_in, float* out, float* ws, hipStream_t stream, int from) {
    using namespace nv;
    const float* state_hgrn = (const float*)d_in[4];
    const float* norm_mix = (const float*)d_in[5];
    const float* norm_ffn = (const float*)d_in[6];
    const float* w_in_c = (const float*)d_in[17];
    const float* c_lower_bounds = (const float*)d_in[18];
    const float* c_out_norm = (const float*)d_in[19];
    const float* w_out_c = (const float*)d_in[20];
    const float* w_gate = (const float*)d_in[21];
    const float* w_up = (const float*)d_in[22];
    const float* w_down = (const float*)d_in[23];
    float* y_prompt = out;
    float* y_sample = y_prompt + (size_t)NB * SEQ * D;
    float* st_prompt = y_sample + (size_t)DEC * D + 2 * 4 * 128 * 128 + 2 * (size_t)128 * 128 * 128 + 4 * 128 * 512 + 128 * 512;
    float* st_sample = st_prompt + (size_t)4 * 8 * 128 * 128;
    float* H = ws;
    float* Z = H + (size_t)4096 * 1024;
    float* V = Z + (size_t)4096 * 4096;
    float* MIX = V + (size_t)4096 * 512;
    float* G = MIX + (size_t)4096 * 1024;
    float* U = G + (size_t)4096 * 2816;
    (void)hipFuncSetAttribute((const void*)k_hgrn_scan, hipFuncAttributeMaxDynamicSharedMemorySize, (128 * 128 + 256) * 4);
    for (int grp = 0; grp < 5; ++grp) {
        const bool smp = (grp == 4);
        const int R = smp ? DEC : SEQ;
        float* x = smp ? y_sample : y_prompt + (size_t)grp * SEQ * D;
        const int rw = (R + 3) / 4;
        for (int l = 0; l < 2; ++l) {
            const int stage_mix = 2 * l, stage_ffn = 2 * l + 1;
            if (stage_mix >= from && l == 1) {
                k_rmsnorm<<<rw, 256, 0, stream>>>(x, norm_mix + l * D, H, R);
                k_gemm<0><<<dim3(C_IN / 64, R / 64), 256, 0, stream>>>(H, D, w_in_c, C_IN, Z, C_IN, D);
                float* O = H;
                if (!smp) {
                    k_hgrn_scan<<<8, 128, (128 * 128 + 256) * 4, stream>>>(Z, c_lower_bounds, nullptr, O, st_prompt + (size_t)grp * 8 * 128 * 128, R);
                } else {
                    for (int b = 0; b < DEC; ++b)
                        k_hgrn_scan<<<8, 128, (128 * 128 + 256) * 4, stream>>>(Z + (size_t)b * C_IN, c_lower_bounds, state_hgrn + (size_t)b * 8 * 128 * 128, O + (size_t)b * D, st_sample + (size_t)b * 8 * 128 * 128, 1);
                }
                k_hgrn_post<<<(R * 8 + 3) / 4, 256, 0, stream>>>(O, Z, c_out_norm, MIX, R);
                k_gemm<1><<<dim3(D / 64, R / 64), 256, 0, stream>>>(MIX, D, w_out_c, D, x, D, D);
            }
            if (stage_ffn >= from) {
                k_rmsnorm<<<rw, 256, 0, stream>>>(x, norm_ffn + l * D, H, R);
                k_gemm<0><<<dim3(FF / 64, R / 64), 256, 0, stream>>>(H, D, w_gate + (size_t)l * D * FF, FF, G, FF, D);
                k_gemm<0><<<dim3(FF / 64, R / 64), 256, 0, stream>>>(H, D, w_up + (size_t)l * D * FF, FF, U, FF, D);
                k_swiglu<<<(int)(((size_t)R * FF + 255) / 256), 256, 0, stream>>>(G, U, G, (size_t)R * FF);
                k_gemm<1><<<dim3(D / 64, R / 64), 256, 0, stream>>>(G, FF, w_down + (size_t)l * FF * D, D, x, D, FF);
            }
        }
    }
}

#endif

extern "C" void kernel_launch(void* const* d_in, const int* in_sizes, int n_in, void* d_out, int out_size, void* d_ws, size_t ws_size, hipStream_t stream) {
    using namespace fk;
    static int ready = 0;
    if (ready == 0) {
        ready = -1;
        if (n_in != 24 || ws_size < WS_END) { fprintf(stderr, "kernel_launch: unexpected n_in %d / ws_size %zu (need %zu)\n", n_in, ws_size, (size_t)WS_END); return; }
        if (hipFuncSetAttribute((const void*)fwd_kernel, hipFuncAttributeMaxDynamicSharedMemorySize, LDS_BYTES) != hipSuccess) { fprintf(stderr, "kernel_launch: hipFuncSetAttribute failed\n"); return; }
        int dev = 0, cus = 0, per_cu = 0;
        (void)hipGetDevice(&dev); (void)hipDeviceGetAttribute(&cus, hipDeviceAttributeMultiprocessorCount, dev);
        (void)hipOccupancyMaxActiveBlocksPerMultiprocessor(&per_cu, (const void*)fwd_kernel, 512, LDS_BYTES);
        if (cus != 256 || per_cu < 1) { fprintf(stderr, "kernel_launch: needs 256 CUs with >= 1 resident block each (cus %d, per_cu %d)\n", cus, per_cu); (void)hipGetLastError(); return; }
        ready = 1;
    }
    if (ready < 0) return;
    (void)hipMemsetAsync((char*)d_ws + WS_CTL, 0, CTL_ZERO_BYTES, stream);
    Args a{};
    for (int i = 0; i < 24; ++i) a.in[i] = (const float*)d_in[i];
    a.out = (float*)d_out; a.ws_ = (unsigned char*)d_ws;
    const int last = (NAIVE_FROM >= 4) ? NPH : (NAIVE_FROM == 3 ? 10 : (NAIVE_FROM == 2 ? 6 : 4));
#if N_LAUNCH_SPLIT
    for (int p = 0; p < last; ++p) { a.ph_lo = p; a.ph_hi = p + 1; hipLaunchKernelGGL(fwd_kernel, dim3(256), dim3(512), LDS_BYTES, stream, a); }
#else
#ifdef PREFIX_PROBE
    a.ph_lo = 0; a.ph_hi = PREFIX_PROBE;
    hipLaunchKernelGGL(fwd_kernel, dim3(256), dim3(512), LDS_BYTES, stream, a);
    (void)hipMemsetAsync((char*)d_ws + WS_CTL, 0, CTL_BYTES, stream);
#endif
    a.ph_lo = 0; a.ph_hi = last;
    hipLaunchKernelGGL(fwd_kernel, dim3(256), dim3(512), LDS_BYTES, stream, a);
#endif
#if NAIVE_FROM < 4
    naive_tail(d_in, (float*)d_out, (float*)d_ws, stream, NAIVE_FROM);
#endif
}
```

```cpp
#include <hip/hip_runtime.h>
#include <math.h>
#include <stdint.h>
#include <cstdio>

#define LAS __attribute__((address_space(3)))
typedef unsigned short bf16_t;
typedef short bf16x8 __attribute__((ext_vector_type(8)));
typedef float f32x4 __attribute__((ext_vector_type(4)));
typedef float f32x2 __attribute__((ext_vector_type(2)));
typedef unsigned u32x4 __attribute__((ext_vector_type(4)));
typedef unsigned u32x2 __attribute__((ext_vector_type(2)));

namespace fk {
constexpr int DM = 1024, SEQ = 4096, NBATCH = 4, DEC = 128;
constexpr int MP = NBATCH * SEQ, MTOT = MP + DEC, MPAD = 16640;
constexpr int N_INAB = 1792, FF = 2816, N_GU = 2 * FF, N_INC = 4096;
constexpr float EPS = 1e-6f;
constexpr float LOG2E = 1.4426950408889634f;
#ifndef NSEG_
#define NSEG_ 8
#endif
constexpr int NSEG = NSEG_, SEGLEN = SEQ / NSEG, CH = 32;

constexpr size_t MiB = 1u << 20;
constexpr size_t WS_CTL = 0, CTL_BYTES = MiB, CTL_ZERO_BYTES = 32768;
constexpr size_t SZ_INAB = (size_t)N_INAB * DM * 2, SZ_SQ = (size_t)DM * DM * 2, SZ_GU = (size_t)N_GU * DM * 2, SZ_DN = (size_t)DM * FF * 2, SZ_INC = (size_t)N_INC * DM * 2;
constexpr size_t WS_W_INAB = 1 * MiB, WS_W_OUTAB = WS_W_INAB + SZ_INAB, WS_W_GU0 = WS_W_OUTAB + SZ_SQ, WS_W_DN0 = WS_W_GU0 + SZ_GU;
constexpr size_t WS_W_INC = WS_W_DN0 + SZ_DN, WS_W_OUTC = WS_W_INC + SZ_INC, WS_W_GU1 = WS_W_OUTC + SZ_SQ, WS_W_DN1 = WS_W_GU1 + SZ_GU;
constexpr size_t WS_WTRIL = WS_W_DN1 + SZ_DN;
constexpr size_t WS_SMALL = 50 * MiB;
constexpr size_t WS_SS = WS_SMALL;
constexpr size_t WS_LNS = WS_SS + (size_t)MPAD * 32 * 4;
constexpr size_t WS_BIAS2 = WS_LNS + (size_t)MPAD * 16 * 4;
constexpr size_t WS_LBT = WS_BIAS2 + 8 * 128 * 4;
constexpr size_t WS_ATOT = WS_LBT + 1024 * 4;
constexpr size_t WS_QS = WS_ATOT + 256 * 128 * 4;
constexpr size_t WS_A = 54 * MiB;
constexpr size_t A_BYTES = (size_t)MPAD * DM * 2;
constexpr size_t WS_B = WS_A + A_BYTES;
constexpr size_t WS_END = WS_B + 5 * A_BYTES;
static_assert(WS_WTRIL + 8 * 128 * 128 * 2 <= WS_SMALL && WS_QS + 128 * 512 * 2 <= WS_A && WS_END <= 256 * MiB, "ws map");
constexpr size_t WS_SLOC = WS_W_INAB;
static_assert(WS_SLOC + (size_t)256 * 128 * 128 * 4 <= WS_W_INC, "sloc overlay");
constexpr size_t B_Q0 = 0, B_K0 = B_Q0 + (size_t)MPAD * 512 * 2, B_V0 = B_K0 + (size_t)MPAD * 128 * 2, B_U0 = B_V0 + (size_t)MPAD * 128 * 2, B_GV0 = B_U0 + (size_t)MPAD * 512 * 2;
constexpr size_t B_XB = 0, B_HID = A_BYTES;
static_assert(B_GV0 + (size_t)MPAD * 512 * 2 <= 5 * A_BYTES && B_HID + (size_t)MPAD * FF * 2 <= 5 * A_BYTES, "B map");
constexpr int CW_BAR = 4096, CW_SPLIT = 2048;

constexpr int RING_BYTES = 131072, MISC_OFF = RING_BYTES + 320, LDS_BYTES = 147456;

typedef __bf16 bf16x2_t __attribute__((ext_vector_type(2)));
__device__ __forceinline__ unsigned cvt_pk_bf16(float lo, float hi) { const f32x2 v = {lo, hi}; const bf16x2_t b = __builtin_convertvector(v, bf16x2_t); return __builtin_bit_cast(unsigned, b); }
__device__ __forceinline__ bf16_t f2bf(float f) { return (bf16_t)(cvt_pk_bf16(f, 0.f) & 0xffffu); }
__device__ __forceinline__ float bf2f(unsigned u) { return __uint_as_float(u << 16); }
__device__ __forceinline__ float bflo(unsigned w) { return __uint_as_float(w << 16); }
__device__ __forceinline__ float bfhi(unsigned w) { return __uint_as_float(w & 0xffff0000u); }
__device__ __forceinline__ unsigned short f2h(float f) { _Float16 h = (_Float16)f; return __builtin_bit_cast(unsigned short, h); }
__device__ __forceinline__ float h2f(unsigned short u) { return (float)__builtin_bit_cast(_Float16, u); }
__device__ __forceinline__ float ex2(float x) { return __builtin_amdgcn_exp2f(x); }
__device__ __forceinline__ float sigm(float x) { return __builtin_amdgcn_rcpf(1.f + ex2(-x * LOG2E)); }
__device__ __forceinline__ float xsum16(float v) { const auto r = __builtin_amdgcn_permlane16_swap(__float_as_uint(v), __float_as_uint(v), false, false); return __uint_as_float(r[0]) + __uint_as_float(r[1]); }
__device__ __forceinline__ float xsum32(float v) { const auto r = __builtin_amdgcn_permlane32_swap(__float_as_uint(v), __float_as_uint(v), false, false); return __uint_as_float(r[0]) + __uint_as_float(r[1]); }
__device__ __forceinline__ float xmax16(float v) { const auto r = __builtin_amdgcn_permlane16_swap(__float_as_uint(v), __float_as_uint(v), false, false); return fmaxf(__uint_as_float(r[0]), __uint_as_float(r[1])); }
__device__ __forceinline__ float xmax32(float v) { const auto r = __builtin_amdgcn_permlane32_swap(__float_as_uint(v), __float_as_uint(v), false, false); return fmaxf(__uint_as_float(r[0]), __uint_as_float(r[1])); }
__device__ __forceinline__ float wsum(float v) {
#pragma unroll
    for (int o = 1; o < 64; o <<= 1) v += __shfl_xor(v, o);
    return v;
}
__device__ __forceinline__ float wmax(float v) {
#pragma unroll
    for (int o = 1; o < 64; o <<= 1) v = fmaxf(v, __shfl_xor(v, o));
    return v;
}
__device__ __forceinline__ f32x2 gelu_pk(f32x2 v) {
    const f32x2 av = __builtin_elementwise_abs(v), d = av * 0.2316418882f + 1.0f;
    f32x2 t; t.x = __builtin_amdgcn_rcpf(d.x); t.y = __builtin_amdgcn_rcpf(d.y);
    f32x2 q = t * 0.5307027145f + (-0.7265760135f); q = q * t + 0.7107068705f; q = q * t + (-0.142248368f); q = q * t + 0.127414796f; q = q * t;
    const f32x2 s = (v * v) * (-0.72134752044f);
    f32x2 e; e.x = ex2(s.x); e.y = ex2(s.y);
    const f32x2 m = v * (q * e), r = v - m;
    f32x2 o; o.x = v.x < 0.f ? m.x : r.x; o.y = v.y < 0.f ? m.y : r.y; return o;
}
__device__ __forceinline__ f32x4 gelu4(f32x4 v) { f32x2 a = gelu_pk((f32x2){v[0], v[1]}), b = gelu_pk((f32x2){v[2], v[3]}); return (f32x4){a.x, a.y, b.x, b.y}; }
__device__ __forceinline__ u32x4 pack8(f32x4 a, f32x4 b) { u32x4 w; w.x = cvt_pk_bf16(a[0], a[1]); w.y = cvt_pk_bf16(a[2], a[3]); w.z = cvt_pk_bf16(b[0], b[1]); w.w = cvt_pk_bf16(b[2], b[3]); return w; }
__device__ __forceinline__ u32x2 pack4(f32x4 a) { u32x2 w; w.x = cvt_pk_bf16(a[0], a[1]); w.y = cvt_pk_bf16(a[2], a[3]); return w; }
__device__ __forceinline__ f32x4 mfma16(bf16x8 a, bf16x8 b, f32x4 c) { return __builtin_amdgcn_mfma_f32_16x16x32_bf16(a, b, c, 0, 0, 0); }

__device__ __constant__ int T5B[128] = {0, 1, 2, 3, 4, 5, 6, 7, 8, 9, 10, 11, 12, 13, 14, 15, 16, 16, 16, 17, 17, 18, 18, 18, 19, 19, 19, 20, 20, 20, 20, 21, 21, 21, 21, 22, 22, 22, 22, 22, 23, 23, 23, 23, 23, 23, 24, 24, 24, 24, 24, 24, 25, 25, 25, 25, 25, 25, 25, 26, 26, 26, 26, 26, 26, 26, 26, 27, 27, 27, 27, 27, 27, 27, 27, 27, 27, 28, 28, 28, 28, 28, 28, 28, 28, 28, 28, 29, 29, 29, 29, 29, 29, 29, 29, 29, 29, 29, 29, 30, 30, 30, 30, 30, 30, 30, 30, 30, 30, 30, 30, 30, 30, 31, 31, 31, 31, 31, 31, 31, 31, 31, 31, 31, 31, 31, 31, 31};

#define XB_TMO      128
#define XB_XCNT(j)  (256  + 64 * (j))
#define XB_XSUB(j)  (1280 + 64 * (j))
#define XB_XGEN(j)  (2304 + 64 * (j))
#define XB_TOP      3328
#define XB_TOPGEN   3392
#define XCD_BAR_WORDS 3456
#define XB_SPIN_CAP (1u << 18)
__device__ __forceinline__ unsigned xb_ld(unsigned* p)              { return __hip_atomic_load(p, __ATOMIC_RELAXED, __HIP_MEMORY_SCOPE_AGENT); }
__device__ __forceinline__ unsigned xb_add(unsigned* p, unsigned v) { return __hip_atomic_fetch_add(p, v, __ATOMIC_RELAXED, __HIP_MEMORY_SCOPE_AGENT); }
__device__ __forceinline__ unsigned xb_xcc_id() { return (unsigned)__builtin_amdgcn_s_getreg((3 << 11) | 20) & 0xFu; }
#define XB_SPIN(cond, bar) do { unsigned _sp = 0; while (cond) { __builtin_amdgcn_s_sleep(1); \
    if ((++_sp & 255u) == 0u) { if (xb_ld(&(bar)[XB_TMO])) break; if (_sp > XB_SPIN_CAP) { atomicAdd(&(bar)[XB_TMO], 1u); break; } } } } while (0)
struct XcdBarrier { unsigned* bar; unsigned x; volatile LAS unsigned* st; };
__device__ __forceinline__ XcdBarrier xcd_barrier_post(unsigned* bar, volatile LAS unsigned* st) {
    XcdBarrier b; b.bar = bar; b.x = xb_xcc_id(); b.st = st;
    if (threadIdx.x == 0) (void)xb_add(&bar[XB_XCNT(b.x)], 1u);
    return b;
}
__device__ __forceinline__ void xcd_barrier_complete(unsigned* bar, unsigned x, unsigned& nloc, unsigned& nx) {
    const unsigned G = gridDim.x * gridDim.y * gridDim.z;
    unsigned sum, cnt, mine, sp = 0u;
    for (;;) {
        sum = 0u; cnt = 0u; mine = 0u;
#pragma unroll
        for (unsigned j = 0; j < 16; ++j) { const unsigned c = xb_ld(&bar[XB_XCNT(j)]); sum += c; cnt += (c > 0u) ? 1u : 0u; mine = (j == x) ? c : mine; }
        if (sum == G) break;
        __builtin_amdgcn_s_sleep(1);
        if ((++sp & 255u) == 0u) { if (xb_ld(&bar[XB_TMO])) break; if (sp > XB_SPIN_CAP) { atomicAdd(&bar[XB_TMO], 1u); break; } }
    }
    nloc = mine > 0u ? mine : 1u; nx = cnt > 0u ? cnt : 1u;
}
__device__ __forceinline__ void split_arrive(unsigned* cnt) {
    asm volatile("s_waitcnt vmcnt(0)" ::: "memory");
    __syncthreads();
    if (threadIdx.x == 0) { __builtin_amdgcn_fence(__ATOMIC_RELEASE, "agent"); asm volatile("s_waitcnt vmcnt(0)" ::: "memory"); (void)xb_add(cnt, 1u); }
}
__device__ __forceinline__ void split_wait(unsigned* cnt, unsigned target, unsigned* bar) {
    if (threadIdx.x == 0) { XB_SPIN(xb_ld(cnt) < target, bar); __builtin_amdgcn_fence(__ATOMIC_ACQUIRE, "agent"); asm volatile("s_waitcnt vmcnt(0)" ::: "memory"); }
    __syncthreads();
}
__device__ __forceinline__ void split_arrive(const XcdBarrier& b, unsigned* w, int stride = 64) {
    asm volatile("s_waitcnt vmcnt(0)" ::: "memory");
    __syncthreads();
    if (threadIdx.x == 0) {
        const unsigned nloc = b.st[0];
        const unsigned old = xb_add(&w[stride * b.x], 1u);
        if (old + 1u == nloc) { __builtin_amdgcn_fence(__ATOMIC_RELEASE, "agent"); asm volatile("s_waitcnt vmcnt(0)" ::: "memory"); (void)xb_add(&w[stride * 16], 1u); }
    }
}
__device__ __forceinline__ void split_wait(const XcdBarrier& b, unsigned* w, int stride = 64) {
    if (threadIdx.x == 0) { const unsigned nx = b.st[1]; XB_SPIN(xb_ld(&w[stride * 16]) < nx, b.bar); __builtin_amdgcn_fence(__ATOMIC_ACQUIRE, "agent"); asm volatile("s_waitcnt vmcnt(0)" ::: "memory"); }
    __syncthreads();
}
#define SPLIT_SET(ws_, k) ((unsigned*)((ws_) + WS_CTL) + 3392 + 136 * (k))
__device__ __forceinline__ void xcd_barrier(const XcdBarrier& b) {
    asm volatile("s_waitcnt vmcnt(0)" ::: "memory");
    __syncthreads();
    if (threadIdx.x == 0) {
        unsigned* bar = b.bar;
        __builtin_amdgcn_s_waitcnt(0);
        unsigned nloc = b.st[0], nx = b.st[1];
        if (nloc == 0u) { xcd_barrier_complete(bar, b.x, nloc, nx); b.st[0] = nloc; b.st[1] = nx; }
        const unsigned old = xb_add(&bar[XB_XSUB(b.x)], 1u);
        const unsigned gen = old / nloc;
        if (old + 1u == (gen + 1u) * nloc) {
            __builtin_amdgcn_fence(__ATOMIC_RELEASE, "agent");
            asm volatile("s_waitcnt vmcnt(0)" ::: "memory");
            const unsigned og = xb_add(&bar[XB_TOP], 1u);
            const unsigned tg = og / nx;
            if (og + 1u == (tg + 1u) * nx) xb_add(&bar[XB_TOPGEN], 1u);
            else XB_SPIN(xb_ld(&bar[XB_TOPGEN]) == tg, bar);
            __builtin_amdgcn_fence(__ATOMIC_ACQUIRE, "agent");
            xb_add(&bar[XB_XGEN(b.x)], 1u);
            asm volatile("s_waitcnt vmcnt(0)" ::: "memory");
        } else {
            XB_SPIN(xb_ld(&bar[XB_XGEN(b.x)]) == gen, bar);
            __builtin_amdgcn_fence(__ATOMIC_ACQUIRE, "agent");
            asm volatile("s_waitcnt vmcnt(0)" ::: "memory");
        }
    }
    __syncthreads();
}

constexpr int BM = 256, BK = 64, HALF = 128, HTB = HALF * BK * 2, NXCD = 8, WGM = 8;
__host__ __device__ __forceinline__ int lds_byte(int r, int c) { const int st = (r >> 4) * 2 + (c >> 5), rr = r & 15, cc = c & 31, ob = rr * 64 + cc * 2; return st * 1024 + (ob ^ (((ob >> 9) & 1) << 5)); }
__host__ __device__ __forceinline__ void stage_rc(int b, int& R, int& C) { const int st = b / 1024, sb = b % 1024, swz = sb ^ (((sb >> 9) & 1) << 5); R = (st >> 1) * 16 + swz / 64; C = (st & 1) * 32 + (swz % 64) / 2; }
struct Unit { int pm, pn; };
struct Gemm { const bf16_t* A; const bf16_t* Bt; int M, N, K; unsigned* ts = nullptr; };
struct StaticOrder {
    int nM, nN, nwg, G, c, rot;
    __device__ void init(int M, int N, int G_, int c_) { nM = M / BM; nN = N / BM; nwg = nM * nN; G = G_; c = c_; rot = 0; }
    __device__ bool next(int i, Unit& u) const {
        const long L = (long)i * G + c; if (L >= nwg) return false;
        int wgid = (int)L; { const int q = nwg / NXCD, r = nwg % NXCD, xcd = wgid % NXCD, off = wgid / NXCD; wgid = (xcd < r ? xcd * (q + 1) : r * (q + 1) + (xcd - r) * q) + off; }
        wgid -= rot; if (wgid < 0) wgid += nwg;
        const int nig = WGM * nN, gid = wgid / nig, fm = gid * WGM, gsz = (nM - fm) < WGM ? (nM - fm) : WGM;
        u.pm = fm + ((wgid % nig) % gsz); u.pn = (wgid % nig) / gsz; return true;
    }
};

template <class Epi, bool ALIGN_EPI>
__device__ __forceinline__ void gemm_phase(LAS unsigned char* lds, const Gemm g, const StaticOrder& S, const Epi& E) {
    const int tid = threadIdx.x, wid = __builtin_amdgcn_readfirstlane(tid >> 6), lane = tid & 63, wr = wid >> 2, wc = wid & 3, fr = lane & 15, fq = lane >> 4;
    const int K = g.K, nt = K / BK;
    unsigned voff[2];
#pragma unroll
    for (int i = 0; i < 2; ++i) { int R, C; stage_rc(tid * 16 + i * 8192, R, C); voff[i] = (unsigned)(R * K + C) * 2u; }
    const size_t kstep = (size_t)(BK * 2);
    const size_t hstep = (size_t)HALF * K * 2;
    const size_t tstep = 2 * hstep;
    const unsigned ldsw = (unsigned)wid * 1024u;
    const int aoff = lds_byte(wr * 64 + fr, fq * 8), boff = lds_byte(wc * 32 + fr, fq * 8);
#define PG8_SA(b, h) (((b) * 2 + (h)) * HTB)
#define PG8_SB(b, h) ((4 + (b) * 2 + (h)) * HTB)
#define PG8_STAGE(bufoff, gbase) do { _Pragma("unroll") for (int _i = 0; _i < 2; ++_i) \
        __builtin_amdgcn_global_load_lds((const unsigned*)((const char*)(gbase) + voff[_i]), (LAS unsigned*)(lds + (bufoff) + ldsw + _i * 8192), 16, 0, 0); } while (0)
#define PG8_LDA(dst, b, h) do { _Pragma("unroll") for (int m = 0; m < 4; ++m) _Pragma("unroll") for (int k = 0; k < 2; ++k) dst[m][k] = *(const LAS bf16x8*)(lds + PG8_SA(b, h) + aoff + m * 2048 + k * 1024); } while (0)
#define PG8_LDB(dst, b, h) do { _Pragma("unroll") for (int n = 0; n < 2; ++n) _Pragma("unroll") for (int k = 0; k < 2; ++k) dst[n][k] = *(const LAS bf16x8*)(lds + PG8_SB(b, h) + boff + n * 2048 + k * 1024); } while (0)
#define PG8_MMA(ai, bj, At, Bt) do { __builtin_amdgcn_s_setprio(1); _Pragma("unroll") for (int m = 0; m < 4; ++m) _Pragma("unroll") for (int n = 0; n < 2; ++n) _Pragma("unroll") for (int k = 0; k < 2; ++k) \
        acc[ai][bj][m][n] = __builtin_amdgcn_mfma_f32_16x16x32_bf16(Bt[n][k], At[m][k], acc[ai][bj][m][n], 0, 0, 0); __builtin_amdgcn_s_setprio(0); } while (0)
#define PG8_WAIT_V(n) asm volatile("s_waitcnt vmcnt(" #n ")" ::: "memory")
#define PG8_WAIT_L(n) asm volatile("s_waitcnt lgkmcnt(" #n ")" ::: "memory")
#define PG8_BAR __builtin_amdgcn_s_barrier()
#define PG8_SCHED __builtin_amdgcn_sched_barrier(0)
    Unit cur, nxt; int ui = 0;
    if (!S.next(0, cur)) return;
    LAS float* rtab = (LAS float*)(lds + RING_BYTES + 1024);
    if constexpr (Epi::USE_RINV) { if (tid < 256) rtab[tid] = E.rinv_row(cur.pm * BM + tid); }
    f32x4 acc[2][2][4][2];
#pragma unroll
    for (int a = 0; a < 2; ++a)
#pragma unroll
        for (int b = 0; b < 2; ++b)
#pragma unroll
            for (int m = 0; m < 4; ++m)
#pragma unroll
                for (int n = 0; n < 2; ++n) acc[a][b][m][n] = (f32x4){0.f, 0.f, 0.f, 0.f};
    bf16x8 At[4][2], B0[2][2], B1[2][2];
    const char* cA = (const char*)g.A + (size_t)cur.pm * tstep; const char* cB = (const char*)g.Bt + (size_t)cur.pn * tstep;
    PG8_STAGE(PG8_SB(0, 0), cB); PG8_STAGE(PG8_SB(0, 1), cB + hstep); PG8_STAGE(PG8_SA(0, 0), cA); PG8_STAGE(PG8_SA(0, 1), cA + hstep);
    if (wr == 1) PG8_BAR;
    PG8_WAIT_V(2); PG8_BAR;
    PG8_STAGE(PG8_SB(1, 0), cB + kstep); PG8_STAGE(PG8_SA(1, 0), cA + kstep); PG8_STAGE(PG8_SB(1, 1), cB + hstep + kstep);
    PG8_WAIT_V(6); PG8_BAR;
    for (;;) {
        const bool has_next = S.next(ui + 1, nxt);
        const char* nA = has_next ? (const char*)g.A + (size_t)nxt.pm * tstep : cA; const char* nB = has_next ? (const char*)g.Bt + (size_t)nxt.pn * tstep : cB;
        for (int t = 0; t < nt; t += 2) {
            const bool last = (t == nt - 2);
            const char* a1 = cA + (size_t)(t + 1) * kstep;
            const char* a2 = last ? nA : cA + (size_t)(t + 2) * kstep; const char* b2 = last ? nB : cB + (size_t)(t + 2) * kstep;
            const char* a3 = a2 + kstep; const char* b3 = b2 + kstep;
            PG8_LDB(B0, 0, 0); PG8_LDB(B1, 0, 1); PG8_SCHED; PG8_LDA(At, 0, 0); PG8_STAGE(PG8_SA(1, 1), a1 + hstep);
            PG8_WAIT_V(8); PG8_WAIT_L(0); PG8_BAR; PG8_MMA(0, 0, At, B0); PG8_MMA(0, 1, At, B1); PG8_BAR; PG8_SCHED;
            PG8_LDA(At, 0, 1); PG8_STAGE(PG8_SB(0, 0), b2); PG8_STAGE(PG8_SB(0, 1), b2 + hstep); PG8_STAGE(PG8_SA(0, 0), a2);
            PG8_WAIT_V(8); PG8_WAIT_L(0); PG8_BAR; PG8_MMA(1, 0, At, B0); PG8_MMA(1, 1, At, B1); PG8_BAR; PG8_SCHED;
            PG8_LDB(B0, 1, 0); PG8_LDB(B1, 1, 1); PG8_SCHED; PG8_LDA(At, 1, 0); PG8_STAGE(PG8_SA(0, 1), a2 + hstep);
            PG8_WAIT_V(8); PG8_WAIT_L(0); PG8_BAR; PG8_MMA(0, 0, At, B0); PG8_MMA(0, 1, At, B1); PG8_BAR; PG8_SCHED;
            PG8_LDA(At, 1, 1); PG8_STAGE(PG8_SB(1, 0), b3); PG8_STAGE(PG8_SB(1, 1), b3 + hstep); PG8_STAGE(PG8_SA(1, 0), a3);
            PG8_WAIT_V(8); PG8_WAIT_L(0); PG8_BAR; PG8_MMA(1, 0, At, B0); PG8_MMA(1, 1, At, B1); PG8_BAR; PG8_SCHED;
        }
        if (g.ts && blockIdx.x == 0 && tid == 0 && ui < 3) g.ts[2 * ui] = (unsigned)__builtin_amdgcn_s_memrealtime();
        if constexpr (ALIGN_EPI) { if (wr == 0) PG8_BAR; }
        float rnext = 0.f;
        if constexpr (Epi::USE_RINV) { if (has_next && tid < 256) rnext = E.rinv_row(nxt.pm * BM + tid); }
        E(acc, cur, wr, wc, fr, fq, rtab + (ui & 1) * 256);
        if constexpr (Epi::USE_RINV) { if (has_next && tid < 256) rtab[((ui + 1) & 1) * 256 + tid] = rnext; }
        if constexpr (Epi::HAS_POST) E.post(cur);
        if (g.ts && blockIdx.x == 0 && tid == 0 && ui < 3) g.ts[2 * ui + 1] = (unsigned)__builtin_amdgcn_s_memrealtime();
        if (!has_next) break;
#pragma unroll
        for (int a = 0; a < 2; ++a)
#pragma unroll
            for (int b = 0; b < 2; ++b)
#pragma unroll
                for (int m = 0; m < 4; ++m)
#pragma unroll
                    for (int n = 0; n < 2; ++n) acc[a][b][m][n] = (f32x4){0.f, 0.f, 0.f, 0.f};
        cur = nxt; cA = nA; cB = nB; ++ui;
        if constexpr (ALIGN_EPI) { if (wr == 1) PG8_BAR; }
    }
    PG8_WAIT_V(0);
    if constexpr (!ALIGN_EPI) { if (wr == 0) PG8_BAR; }
    PG8_BAR;
#undef PG8_SA
#undef PG8_SB
#undef PG8_STAGE
#undef PG8_LDA
#undef PG8_LDB
#undef PG8_MMA
#undef PG8_WAIT_V
#undef PG8_WAIT_L
#undef PG8_BAR
#undef PG8_SCHED
}
}
namespace fk {
#ifdef TPROBE_A
constexpr int TS_WORD0 = 1024;
__device__ __forceinline__ unsigned tnow() { return (unsigned)__builtin_amdgcn_s_memrealtime(); }
#define TSTAMP_BEG(k) do { if (blockIdx.x == 0 && threadIdx.x == 0) ((unsigned*)(ws + WS_CTL))[TS_WORD0 + (k)] = tnow(); } while (0)
#define TSTAMP_MAX(slot) do { if (threadIdx.x == 0) { atomicMax((unsigned*)(ws + WS_CTL) + TS_WORD0 + (slot), tnow()); } } while (0)
#define TSTAMP_END(k) do { if (threadIdx.x == 0) { const unsigned t_ = tnow(); atomicMax((unsigned*)(ws + WS_CTL) + TS_WORD0 + 16 + (k), t_); atomicMax((unsigned*)(ws + WS_CTL) + TS_WORD0 + 32 + (k), ~t_); } } while (0)
#else
#define TSTAMP_MAX(slot) do {} while (0)
#define TSTAMP_BEG(k) do {} while (0)
#define TSTAMP_END(k) do {} while (0)
#endif
struct Args {
    const float* in[24]; float* out; unsigned char* ws_; int ph_lo, ph_hi;
    __device__ __forceinline__ const float* x_prompt() const { return in[0]; }
    __device__ __forceinline__ const float* x_sample() const { return in[1]; }
    __device__ __forceinline__ const float* cache_k() const { return in[2]; }
    __device__ __forceinline__ const float* cache_v() const { return in[3]; }
    __device__ __forceinline__ const float* state_hgrn() const { return in[4]; }
    __device__ __forceinline__ const float* norm_mix() const { return in[5]; }
    __device__ __forceinline__ const float* norm_ffn() const { return in[6]; }
    __device__ __forceinline__ const float* w_in_ab() const { return in[7]; }
    __device__ __forceinline__ const float* w_out_ab() const { return in[8]; }
    __device__ __forceinline__ const float* q_norm() const { return in[9]; }
    __device__ __forceinline__ const float* k_norm() const { return in[10]; }
    __device__ __forceinline__ const float* attn_sink() const { return in[11]; }
    __device__ __forceinline__ const float* rel_bias() const { return in[12]; }
    __device__ __forceinline__ const float* gmlp_ln_g() const { return in[13]; }
    __device__ __forceinline__ const float* gmlp_ln_b() const { return in[14]; }
    __device__ __forceinline__ const float* gmlp_w_s() const { return in[15]; }
    __device__ __forceinline__ const float* gmlp_b_s() const { return in[16]; }
    __device__ __forceinline__ const float* w_in_c() const { return in[17]; }
    __device__ __forceinline__ const float* c_lb() const { return in[18]; }
    __device__ __forceinline__ const float* c_out_norm() const { return in[19]; }
    __device__ __forceinline__ const float* w_out_c() const { return in[20]; }
    __device__ __forceinline__ const float* w_gate() const { return in[21]; }
    __device__ __forceinline__ const float* w_up() const { return in[22]; }
    __device__ __forceinline__ const float* w_down() const { return in[23]; }
    __device__ __forceinline__ unsigned char* ws() const { return ws_; }
    __device__ __forceinline__ float* X() const { return out; }
    __device__ __forceinline__ float* nkp() const { return out + (size_t)MTOT * DM; }
    __device__ __forceinline__ float* nvp() const { return nkp() + 4 * 128 * 128; }
    __device__ __forceinline__ float* nks() const { return nvp() + 4 * 128 * 128; }
    __device__ __forceinline__ float* nvs() const { return nks() + (size_t)128 * 128 * 128; }
    __device__ __forceinline__ float* gvp() const { return nvs() + (size_t)128 * 128 * 128; }
    __device__ __forceinline__ float* gvs() const { return gvp() + 4 * 128 * 512; }
    __device__ __forceinline__ float* stp() const { return gvs() + 128 * 512; }
    __device__ __forceinline__ float* sts() const { return stp() + (size_t)4 * 8 * 16384; }
};

__device__ __forceinline__ int slot_col(int map, int np, int& which) {
    const int pn = np >> 8, s = np & 255, bj = s >> 7, wc = (s >> 5) & 3, n = (s >> 4) & 1, fq = (s >> 2) & 3, e = s & 3;
    which = 0;
    if (map == 0) return 256 * pn + 64 * wc + 32 * bj + 8 * fq + 4 * n + e;
    if (map == 1) return 256 * pn + 128 * bj + 32 * wc + 8 * fq + 4 * n + e;
    which = n; return 128 * pn + 32 * wc + 8 * fq + 4 * bj + e;
}
__device__ __forceinline__ void wconv_item(LAS unsigned char* lds, const float* w_s0, const float* w_s1, const int w_srcN, const float* w_gs, bf16_t* w_dst, const int w_K, const int w_map, const int w_nnt, int item) {
    const int tid = threadIdx.x, lane = tid & 63, wv = tid >> 6;
    const int nt = item % w_nnt, kt = item / w_nnt, n0 = nt * 64, k0 = kt * 64;
    LAS bf16_t* T = (LAS bf16_t*)lds;
    int which; const int col = slot_col(w_map, n0 + lane, which);
    const float* src = which ? w_s1 : w_s0;
#pragma unroll
    for (int j = 0; j < 8; ++j) {
        const int k = k0 + wv * 8 + j;
        float v = src[(size_t)k * w_srcN + col];
        if (w_gs) v *= w_gs[k];
        T[lane * 66 + wv * 8 + j] = f2bf(v);
    }
    __syncthreads();
    {
        const int row = tid >> 3, ch = tid & 7;
        const LAS unsigned* p = (const LAS unsigned*)(T + row * 66 + ch * 8);
        u32x4 o; o.x = p[0]; o.y = p[1]; o.z = p[2]; o.w = p[3];
        *(u32x4*)(w_dst + (size_t)(n0 + row) * w_K + k0 + ch * 8) = o;
    }
    __syncthreads();
}
__device__ __forceinline__ void wconv_load256(const float* s0, const float* s1, const int srcN, const int map, const int pn, const int kt, f32x4 (&v)[8]) {
    const int tid = threadIdx.x, c4 = tid & 63, kg = tid >> 6;
    const int k0 = kt * 64;
    const float* src; int col;
    if (map == 2) { src = (c4 < 32) ? s0 : s1; col = 128 * pn + 4 * (c4 & 31); } else { src = s0; col = 256 * pn + 4 * c4; }
#pragma unroll
    for (int r = 0; r < 8; ++r) v[r] = *(const f32x4*)(src + (size_t)(k0 + kg * 8 + r) * srcN + col);
}
__device__ __forceinline__ void wconv_finish256(LAS unsigned char* lds, f32x4 (&v)[8], const float* gs, bf16_t* dst, const int K, const int map, const int pn, const int kt) {
    const int tid = threadIdx.x, c4 = tid & 63, kg = tid >> 6;
    const int k0 = kt * 64;
    LAS bf16_t* TT = (LAS bf16_t*)lds;
    if (gs) {
#pragma unroll
        for (int r = 0; r < 8; ++r) v[r] = v[r] * gs[k0 + kg * 8 + r];
    }
#pragma unroll
    for (int i = 0; i < 4; ++i) {
        LAS unsigned* tw = (LAS unsigned*)(TT + (4 * c4 + i) * 66 + kg * 8);
        tw[0] = cvt_pk_bf16(v[0][i], v[1][i]); tw[1] = cvt_pk_bf16(v[2][i], v[3][i]); tw[2] = cvt_pk_bf16(v[4][i], v[5][i]); tw[3] = cvt_pk_bf16(v[6][i], v[7][i]);
    }
    __syncthreads();
#pragma unroll
    for (int q = 0; q < 4; ++q) {
        const int idx = tid + 512 * q, s = idx >> 3, ch = idx & 7;
        const int bj = s >> 7, wc = (s >> 5) & 3, n = (s >> 4) & 1, fq = (s >> 2) & 3, e = s & 3;
        const int nl = (map == 0) ? 64 * wc + 32 * bj + 8 * fq + 4 * n + e : (map == 1) ? 128 * bj + 32 * wc + 8 * fq + 4 * n + e : 128 * n + 32 * wc + 8 * fq + 4 * bj + e;
        const LAS unsigned* p = (const LAS unsigned*)(TT + nl * 66 + ch * 8);
        u32x4 o; o.x = p[0]; o.y = p[1]; o.z = p[2]; o.w = p[3];
        *(u32x4*)(dst + (size_t)(256 * pn + s) * K + k0 + ch * 8) = o;
    }
    __syncthreads();
}
__device__ __forceinline__ void wconv_item256(LAS unsigned char* lds, const float* s0, const float* s1, const int srcN, const float* gs, bf16_t* dst, const int K, const int map, const int pn, const int kt) {
    f32x4 v[8];
    wconv_load256(s0, s1, srcN, map, pn, kt, v);
    wconv_finish256(lds, v, gs, dst, K, map, pn, kt);
}
#ifndef GU0_IN_P0
#define GU0_IN_P0 80
#endif
__device__ __forceinline__ void p0_prologue(const Args& P, LAS unsigned char* lds) {
    const int tid = threadIdx.x, lane = tid & 63, wv = tid >> 6, blk = blockIdx.x, G = gridDim.x;
    unsigned char* ws = P.ws();
    constexpr int NI0 = 7 * 16, NI1 = NI0 + 4 * 16, NI2 = NI1 + GU0_IN_P0;
    static_assert(NI2 <= 256, "one item per workgroup");
    const bool has_item = blk < NI2;
    const float *ws0 = P.w_in_ab(), *ws1 = nullptr, *wgs = P.norm_mix(); int wsrcN = N_INAB, wmap = 0, wpn = blk % 7, wkt = blk / 7; bf16_t* wdst = (bf16_t*)(ws + WS_W_INAB);
    if (blk >= NI1)      { const int g = blk - NI1; ws0 = P.w_gate(); ws1 = P.w_up(); wgs = P.norm_ffn(); wsrcN = FF; wmap = 2; wpn = g % 22; wkt = g / 22; wdst = (bf16_t*)(ws + WS_W_GU0); }
    else if (blk >= NI0) { const int g = blk - NI0; ws0 = P.w_out_ab(); wgs = nullptr; wsrcN = DM; wmap = 1; wpn = g % 4; wkt = g / 4; wdst = (bf16_t*)(ws + WS_W_OUTAB); }
    bf16_t* XB = (bf16_t*)P.X();
    float* SS = (float*)(ws + WS_SS);
    {
        f32x4 xv[8][4]; int rows[8];
#pragma unroll
        for (int i = 0; i < 8; ++i) {
            int row = blk * 8 + wv + i * G * 8; rows[i] = row; if (row >= MTOT) row = 0;
            const float* xr = (row < MP) ? P.x_prompt() + (size_t)row * DM : P.x_sample() + (size_t)(row - MP) * DM;
#pragma unroll
            for (int j = 0; j < 4; ++j) xv[i][j] = *(const f32x4*)(xr + 4 * lane + 256 * j);
        }
        f32x4 wv8[8];
        if (has_item) wconv_load256(ws0, ws1, wsrcN, wmap, wpn, wkt, wv8);
#pragma unroll
        for (int i = 0; i < 8; ++i) {
            if (rows[i] < MTOT) {
                float sacc = 0.f;
#pragma unroll
                for (int j = 0; j < 4; ++j) { sacc += (xv[i][j][0] * xv[i][j][0] + xv[i][j][1] * xv[i][j][1]) + (xv[i][j][2] * xv[i][j][2] + xv[i][j][3] * xv[i][j][3]); *(u32x2*)(XB + (size_t)rows[i] * DM + 4 * lane + 256 * j) = pack4(xv[i][j]); }
                sacc = wsum(sacc);
                if (lane < 32) SS[(size_t)rows[i] * 32 + lane] = (lane == 0) ? sacc : 0.f;
            }
        }
        if (has_item) wconv_finish256(lds, wv8, wgs, wdst, DM, wmap, wpn, wkt);
        TSTAMP_MAX(13);
        for (int row = blk * 8 + wv + 8 * G * 8; row < MTOT; row += G * 8) {
            const float* xr = (row < MP) ? P.x_prompt() + (size_t)row * DM : P.x_sample() + (size_t)(row - MP) * DM;
            float sacc = 0.f;
#pragma unroll
            for (int j = 0; j < 4; ++j) { const f32x4 vq = *(const f32x4*)(xr + 4 * lane + 256 * j); sacc += (vq[0] * vq[0] + vq[1] * vq[1]) + (vq[2] * vq[2] + vq[3] * vq[3]); *(u32x2*)(XB + (size_t)row * DM + 4 * lane + 256 * j) = pack4(vq); }
            sacc = wsum(sacc);
            if (lane < 32) SS[(size_t)row * 32 + lane] = (lane == 0) ? sacc : 0.f;
        }
    }
    TSTAMP_MAX(14);
    {
        const int i = blk * 512 + tid;
        { const int t = (i >> 7) & 127, sidx = i & 127; ((bf16_t*)(ws + WS_WTRIL))[i] = (sidx <= t) ? f2bf(P.gmlp_w_s()[i]) : (bf16_t)0; }
        if (i < 1024) { const int h = i >> 7, d = i & 127; ((float*)(ws + WS_BIAS2))[i] = P.rel_bias()[T5B[d] * 8 + h] * LOG2E; }
        else if (i < 2048) { const int c = i - 1024; const float c0 = P.c_lb()[c], c1 = P.c_lb()[1024 + c]; ((float*)(ws + WS_LBT))[c] = 1.f / (1.f + expf(c0 - c1)); }
    }
}

__device__ __forceinline__ void wconv_deferred2(const Args& P, LAS unsigned char* lds, int which, int me, int nb);
__device__ __forceinline__ void wconv_deferred(const Args& P, LAS unsigned char* lds, int which, int first) {
    wconv_deferred2(P, lds, which, (int)blockIdx.x - first, (int)gridDim.x - first);
}
__device__ __forceinline__ void wconv_deferred2(const Args& P, LAS unsigned char* lds, int which, int me, int nb) {
    if (me < 0) return;
    unsigned char* ws = P.ws();
    if (which == 0) {
        for (int i = GU0_IN_P0 + me; i < 22 * 16; i += nb) wconv_item256(lds, P.w_gate(), P.w_up(), FF, P.norm_ffn(), (bf16_t*)(ws + WS_W_GU0), DM, 2, i % 22, i / 22);
        for (int i = me; i < 4 * 44; i += nb) wconv_item256(lds, P.w_down(), nullptr, DM, nullptr, (bf16_t*)(ws + WS_W_DN0), FF, 1, i % 4, i / 4);
    } else if (which == 1) {
        for (int i = me; i < 22 * 16; i += nb) wconv_item256(lds, P.w_gate() + (size_t)DM * FF, P.w_up() + (size_t)DM * FF, FF, P.norm_ffn() + DM, (bf16_t*)(ws + WS_W_GU1), DM, 2, i % 22, i / 22);
        for (int i = me; i < 16 * 16; i += nb) wconv_item256(lds, P.w_in_c(), nullptr, N_INC, P.norm_mix() + DM, (bf16_t*)(ws + WS_W_INC), DM, 1, i % 16, i / 16);
    } else {
        for (int i = me; i < 4 * 16; i += nb) wconv_item256(lds, P.w_out_c(), nullptr, DM, nullptr, (bf16_t*)(ws + WS_W_OUTC), DM, 1, i % 4, i / 4);
        for (int i = me; i < 4 * 44; i += nb) wconv_item256(lds, P.w_down() + (size_t)FF * DM, nullptr, DM, nullptr, (bf16_t*)(ws + WS_W_DN1), FF, 1, i % 4, i / 4);
    }
}

__device__ __forceinline__ float row_rinv(const float* SS, int row) {
    const f32x4* p = (const f32x4*)(SS + (size_t)row * 32);
    float s = 0.f;
#pragma unroll
    for (int i = 0; i < 8; ++i) { const f32x4 a = p[i]; s += (a[0] + a[1]) + (a[2] + a[3]); }
    return rsqrtf(s * (1.f / DM) + EPS);
}
__device__ __forceinline__ float sum4(f32x4 v) { return (v[0] + v[1]) + (v[2] + v[3]); }
__device__ __forceinline__ float sumsq4(f32x4 v) { return (v[0] * v[0] + v[1] * v[1]) + (v[2] * v[2] + v[3] * v[3]); }

struct EpiInAb {
    static constexpr bool HAS_POST = false;
    static constexpr bool USE_RINV = true;
    __device__ __forceinline__ float rinv_row(int row) const { return row_rinv(SS, row); }
    const float* SS; bf16_t *Q, *K, *V, *U, *GV; float* LNS; const float *qn, *kn; float *nkp, *nvp, *nks, *nvs; bf16_t* QSb;
    __device__ __forceinline__ void operator()(const f32x4 (&acc)[2][2][4][2], const Unit& u, int wr, int wc, int fr, int fq, const LAS float* rt) const {
        if (u.pm * BM + BM <= MTOT) body<false>(acc, u, wr, wc, fr, fq, rt); else body<true>(acc, u, wr, wc, fr, fq, rt);
    }
    template <bool CHECK> __device__ __forceinline__ void body(const f32x4 (&acc)[2][2][4][2], const Unit& u, int wr, int wc, int fr, int fq, const LAS float* rt) const {
        const int pn = u.pn;
        f32x4 nwv[2][2];
        {
            const bool isq_ = pn < 2, isk_ = (pn == 2 && wc < 2);
            const float* nw_ = isq_ ? qn : kn;
#pragma unroll
            for (int bj = 0; bj < 2; ++bj) { nwv[bj][0] = (isq_ || isk_) ? *(const f32x4*)(nw_ + 32 * bj + 8 * fq) : (f32x4){0.f, 0.f, 0.f, 0.f}; nwv[bj][1] = (isq_ || isk_) ? *(const f32x4*)(nw_ + 32 * bj + 8 * fq + 4) : (f32x4){0.f, 0.f, 0.f, 0.f}; }
        }
#pragma unroll
        for (int ai = 0; ai < 2; ++ai)
#pragma unroll
            for (int m = 0; m < 4; ++m) {
                const int row = u.pm * BM + ai * HALF + wr * 64 + m * 16 + fr;
                if (CHECK && row >= MTOT) continue;
                const float rinv = rt[ai * HALF + wr * 64 + m * 16 + fr];
                f32x4 v[2][2];
#pragma unroll
                for (int bj = 0; bj < 2; ++bj)
#pragma unroll
                    for (int n = 0; n < 2; ++n) v[bj][n] = acc[ai][bj][m][n] * rinv;
                const int d0 = 8 * fq;
                if (pn < 2 || (pn == 2 && wc < 2)) {
                    float ss = (sumsq4(v[0][0]) + sumsq4(v[0][1])) + (sumsq4(v[1][0]) + sumsq4(v[1][1]));
                    ss = xsum32(xsum16(ss));
                    const float r = rsqrtf(ss * (1.f / 64.f) + EPS);
                    const bool isq = pn < 2;
                    const float sc = isq ? r * (0.125f * LOG2E) : r;
                    bf16_t* dst = isq ? (CHECK ? QSb : Q) + (size_t)row * 512 + (4 * pn + wc) * 64 : K + (size_t)row * 128 + wc * 64;
                    float* fo = nullptr;
                    if (!isq) {
                        if ((u.pm & 15) == 15 && ai == 1) { const int b = u.pm >> 4, i = row - (b * SEQ + SEQ - 128); fo = nkp + ((size_t)(b * 128 + i) * 2 + wc) * 64; }
                        if (u.pm == 64) { const int b = row - MP; fo = nks + ((size_t)(b * 128 + 127) * 2 + wc) * 64; }
                    }
#pragma unroll
                    for (int bj = 0; bj < 2; ++bj) {
                        const f32x4 w0 = nwv[bj][0], w1 = nwv[bj][1];
                        const f32x4 o0 = v[bj][0] * w0 * sc, o1 = v[bj][1] * w1 * sc;
                        *(u32x4*)(dst + 32 * bj + d0) = pack8(o0, o1);
                        if (fo) { *(f32x4*)(fo + 32 * bj + d0) = o0; *(f32x4*)(fo + 32 * bj + d0 + 4) = o1; }
                    }
                } else if (pn == 2) {
                    const int kvh = wc - 2;
                    bf16_t* dst = V + (size_t)row * 128 + kvh * 64;
                    float* fo = nullptr;
                    if ((u.pm & 15) == 15 && ai == 1) { const int b = u.pm >> 4, i = row - (b * SEQ + SEQ - 128); fo = nvp + ((size_t)(b * 128 + i) * 2 + kvh) * 64; }
                    if (u.pm == 64) { const int b = row - MP; fo = nvs + ((size_t)(b * 128 + 127) * 2 + kvh) * 64; }
#pragma unroll
                    for (int bj = 0; bj < 2; ++bj) {
                        *(u32x4*)(dst + 32 * bj + d0) = pack8(v[bj][0], v[bj][1]);
                        if (fo) { *(f32x4*)(fo + 32 * bj + d0) = v[bj][0]; *(f32x4*)(fo + 32 * bj + d0 + 4) = v[bj][1]; }
                    }
                } else if (pn < 5) {
                    bf16_t* dst = U + (size_t)row * 512 + (pn - 3) * 256 + wc * 64;
#pragma unroll
                    for (int bj = 0; bj < 2; ++bj) *(u32x4*)(dst + 32 * bj + d0) = pack8(gelu4(v[bj][0]), gelu4(v[bj][1]));
                } else {
                    bf16_t* dst = GV + (size_t)row * 512 + (pn - 5) * 256 + wc * 64;
                    float s1 = 0.f, s2 = 0.f;
#pragma unroll
                    for (int bj = 0; bj < 2; ++bj) {
                        const f32x4 g0 = gelu4(v[bj][0]), g1 = gelu4(v[bj][1]);
                        s1 += sum4(g0) + sum4(g1); s2 += sumsq4(g0) + sumsq4(g1);
                        *(u32x4*)(dst + 32 * bj + d0) = pack8(g0, g1);
                    }
                    s1 = xsum32(xsum16(s1));
                    s2 = xsum32(xsum16(s2));
                    if (fq == 0) *(f32x2*)(LNS + (size_t)row * 16 + ((pn - 5) * 4 + wc) * 2) = (f32x2){s1, s2};
                }
            }
    }
};

template <int MODE> struct EpiRes {
    static constexpr bool HAS_POST = false;
    static constexpr bool USE_RINV = false;
    __device__ __forceinline__ float rinv_row(int) const { return 0.f; }
    const float* xin_p; const float* xin_s; const bf16_t* RB_;
    bf16_t* OB; float* OF; float* SS;
    __device__ __forceinline__ void operator()(const f32x4 (&acc)[2][2][4][2], const Unit& u, int wr, int wc, int fr, int fq, const LAS float* rt) const {
#pragma unroll
        for (int ai = 0; ai < 2; ++ai) {
            f32x4 pre[4][2][2];
#pragma unroll
            for (int m = 0; m < 4; ++m) {
                const int row = u.pm * BM + ai * HALF + wr * 64 + m * 16 + fr;
                const int rr = row < MTOT ? row : 0;
#pragma unroll
                for (int bj = 0; bj < 2; ++bj) {
                    const int c0 = u.pn * BM + bj * HALF + wc * 32 + 8 * fq;
                    if (MODE == 0) {
                        const float* src = (rr < MP) ? xin_p + (size_t)rr * DM : xin_s + (size_t)(rr - MP) * DM;
                        pre[m][bj][0] = *(const f32x4*)(src + c0); pre[m][bj][1] = *(const f32x4*)(src + c0 + 4);
                    } else {
                        const u32x4 w = *(const u32x4*)(RB_ + (size_t)rr * DM + c0);
                        pre[m][bj][0] = (f32x4){bflo(w.x), bfhi(w.x), bflo(w.y), bfhi(w.y)}; pre[m][bj][1] = (f32x4){bflo(w.z), bfhi(w.z), bflo(w.w), bfhi(w.w)};
                    }
                }
            }
            asm volatile("" ::: "memory");
#pragma unroll
            for (int m = 0; m < 4; ++m) {
                const int row = u.pm * BM + ai * HALF + wr * 64 + m * 16 + fr;
                if (row >= MTOT) continue;
                float ss = 0.f;
#pragma unroll
                for (int bj = 0; bj < 2; ++bj) {
                    const int c0 = u.pn * BM + bj * HALF + wc * 32 + 8 * fq;
                    const f32x4 o0 = pre[m][bj][0] + acc[ai][bj][m][0], o1 = pre[m][bj][1] + acc[ai][bj][m][1];
                    if (MODE == 2) { *(f32x4*)(OF + (size_t)row * DM + c0) = o0; *(f32x4*)(OF + (size_t)row * DM + c0 + 4) = o1; }
                    else { *(u32x4*)(OB + (size_t)row * DM + c0) = pack8(o0, o1); ss += sumsq4(o0) + sumsq4(o1); }
                }
                if (MODE != 2) {
                    ss = xsum32(xsum16(ss));
                    if (fq == 0) SS[(size_t)row * 32 + u.pn * 4 + wc] = ss;
                }
            }
            asm volatile("" ::: "memory");
        }
    }
};

struct EpiGU {
    static constexpr bool USE_RINV = true, HAS_POST = true;
    __device__ __forceinline__ float rinv_row(int row) const { return row_rinv(SS, row); }
    const float* SS; bf16_t* HID; unsigned* sig;
    __device__ __forceinline__ void operator()(const f32x4 (&acc)[2][2][4][2], const Unit& u, int wr, int wc, int fr, int fq, const LAS float* rt) const {
        if (u.pm * BM + BM <= MTOT) body<false>(acc, u, wr, wc, fr, fq, rt); else body<true>(acc, u, wr, wc, fr, fq, rt);
    }
    __device__ __forceinline__ void post(const Unit& u) const {
        if (sig && u.pm * BM + BM > MTOT && (threadIdx.x & 63) == 0)
            asm volatile("s_waitcnt vmcnt(0)\n\tglobal_atomic_add %0, %1, off sc1" :: "v"(sig), "v"(1u) : "memory");
    }
    template <bool CHECK> __device__ __forceinline__ void body(const f32x4 (&acc)[2][2][4][2], const Unit& u, int wr, int wc, int fr, int fq, const LAS float* rt) const {
#pragma unroll
        for (int ai = 0; ai < 2; ++ai)
#pragma unroll
            for (int m = 0; m < 4; ++m) {
                const int row = u.pm * BM + ai * HALF + wr * 64 + m * 16 + fr;
                if (CHECK && row >= MTOT) continue;
                const float rinv = rt[ai * HALF + wr * 64 + m * 16 + fr];
                f32x4 h[2];
#pragma unroll
                for (int bj = 0; bj < 2; ++bj) {
                    const f32x4 ag = acc[ai][bj][m][0], gu = ag * acc[ai][bj][m][1] * (rinv * rinv), xe = ag * (-LOG2E * rinv);
#pragma unroll
                    for (int e = 0; e < 4; ++e) h[bj][e] = gu[e] * __builtin_amdgcn_rcpf(1.f + ex2(xe[e]));
                }
                if (CHECK) { const u32x4 hv = pack8(h[0], h[1]); asm volatile("global_store_dwordx4 %0, %1, off sc1" :: "v"(HID + (size_t)row * FF + u.pn * 128 + wc * 32 + 8 * fq), "v"(hv) : "memory"); }
                else *(u32x4*)(HID + (size_t)row * FF + u.pn * 128 + wc * 32 + 8 * fq) = pack8(h[0], h[1]);
            }
    }
};

struct EpiInC {
    static constexpr bool HAS_POST = false;
    static constexpr bool USE_RINV = true;
    __device__ __forceinline__ float rinv_row(int row) const { return row_rinv(SS, row); }
    const float* SS; const float* LBT; bf16_t *Q1, *K1, *I1, *SG1; unsigned short* LF; const LAS float* LBs;
    __device__ __forceinline__ void operator()(const f32x4 (&acc)[2][2][4][2], const Unit& u, int wr, int wc, int fr, int fq, const LAS float* rt) const {
        const int type = u.pn >> 2, cb = (u.pn & 3) * 256;
#pragma unroll
        for (int ai = 0; ai < 2; ++ai)
#pragma unroll
            for (int m = 0; m < 4; ++m) {
                const int row = u.pm * BM + ai * HALF + wr * 64 + m * 16 + fr;
                if (row >= MTOT) continue;
                const float rinv = rt[ai * HALF + wr * 64 + m * 16 + fr];
#pragma unroll
                for (int bj = 0; bj < 2; ++bj) {
                    const int c0 = cb + bj * HALF + wc * 32 + 8 * fq;
                    const f32x4 v0 = acc[ai][bj][m][0] * rinv, v1 = acc[ai][bj][m][1] * rinv;
                    const f32x4 x0 = acc[ai][bj][m][0] * (-LOG2E * rinv), x1 = acc[ai][bj][m][1] * (-LOG2E * rinv);
                    const size_t off = (size_t)row * DM + c0;
                    if (type == 0) *(u32x4*)(Q1 + off) = pack8(v0, v1);
                    else if (type == 2) *(u32x4*)(I1 + off) = pack8(v0, v1);
                    else if (type == 3) {
                        f32x4 s0, s1;
#pragma unroll
                        for (int e = 0; e < 4; ++e) { s0[e] = __builtin_amdgcn_rcpf(1.f + ex2(x0[e])); s1[e] = __builtin_amdgcn_rcpf(1.f + ex2(x1[e])); }
                        *(u32x4*)(SG1 + off) = pack8(s0, s1);
                    } else {
                        const f32x4 l0 = *(const LAS f32x4*)(LBs + c0), l1 = *(const LAS f32x4*)(LBs + c0 + 4);
                        u32x4 lw;
                        float lf[8];
#pragma unroll
                        for (int e = 0; e < 4; ++e) {
                            const float f0 = l0[e] + (1.f - l0[e]) * __builtin_amdgcn_rcpf(1.f + ex2(x0[e])), f1 = l1[e] + (1.f - l1[e]) * __builtin_amdgcn_rcpf(1.f + ex2(x1[e]));
                            lf[e] = f0; lf[4 + e] = f1;
                        }
                        lw.x = (unsigned)f2h(lf[0]) | ((unsigned)f2h(lf[1]) << 16); lw.y = (unsigned)f2h(lf[2]) | ((unsigned)f2h(lf[3]) << 16);
                        lw.z = (unsigned)f2h(lf[4]) | ((unsigned)f2h(lf[5]) << 16); lw.w = (unsigned)f2h(lf[6]) | ((unsigned)f2h(lf[7]) << 16);
                        *(u32x4*)(LF + off) = lw;
                    }
                }
            }
    }
};
}
namespace fk {
typedef short v4i16_t __attribute__((ext_vector_type(4)));
__device__ __forceinline__ v4i16_t vtr4(const LAS bf16_t* p) { return __builtin_amdgcn_ds_read_tr16_b64_v4i16((LAS v4i16_t*)p); }
__device__ __forceinline__ void attn_prompt_unit(const Args& P, LAS unsigned char* lds, int b, int qb, int kvh) {
    const int tid = threadIdx.x, lane = tid & 63, w = __builtin_amdgcn_readfirstlane(tid >> 6), li = lane & 15, gq = lane >> 4;
    unsigned char* ws = P.ws();
    const bf16_t* Q = (const bf16_t*)(ws + WS_B + B_Q0); const bf16_t* K = (const bf16_t*)(ws + WS_B + B_K0); const bf16_t* V = (const bf16_t*)(ws + WS_B + B_V0);
    bf16_t* MIX = (bf16_t*)(ws + WS_A);
    LAS bf16_t* KS = (LAS bf16_t*)lds;
    LAS bf16_t* VT = (LAS bf16_t*)(lds + 36864);
    LAS float* B2 = (LAS float*)(lds + 36864 + 33280);
    LAS float* SK = B2 + 512;
    const int rowbase = b * SEQ + qb * 128 - 128;
    bf16x8 qn0, qn1;
    const bf16_t* qbase = Q + ((size_t)b * SEQ + qb * 128 + 64 * (w & 1) + li) * 512 + (4 * kvh + (w >> 1)) * 64 + 8 * gq;
    qn0 = *(const bf16x8*)(qbase); qn1 = *(const bf16x8*)(qbase + 32);
#pragma unroll
    for (int i = 0; i < 4; ++i) {
        const int p = tid + 512 * i, j = p >> 3, ch = p & 7;
        u32x4 kv4 = (u32x4){0u, 0u, 0u, 0u}, vv4 = (u32x4){0u, 0u, 0u, 0u};
        if (qb > 0 || j >= 128) {
            kv4 = *(const u32x4*)(K + (size_t)(rowbase + j) * 128 + kvh * 64 + ch * 8);
            vv4 = *(const u32x4*)(V + (size_t)(rowbase + j) * 128 + kvh * 64 + ch * 8);
        }
        *(LAS u32x4*)(KS + j * 72 + ch * 8) = kv4;
        LAS bf16_t* vt = VT + (ch * 8) * 260 + j;
        vt[0 * 260] = (bf16_t)(vv4.x & 0xffffu); vt[1 * 260] = (bf16_t)(vv4.x >> 16);
        vt[2 * 260] = (bf16_t)(vv4.y & 0xffffu); vt[3 * 260] = (bf16_t)(vv4.y >> 16);
        vt[4 * 260] = (bf16_t)(vv4.z & 0xffffu); vt[5 * 260] = (bf16_t)(vv4.z >> 16);
        vt[6 * 260] = (bf16_t)(vv4.w & 0xffffu); vt[7 * 260] = (bf16_t)(vv4.w >> 16);
    }
    { const float* B2g = (const float*)(ws + WS_BIAS2); B2[tid] = B2g[(4 * kvh + (tid >> 7)) * 128 + (tid & 127)]; if (tid < 4) SK[tid] = P.attn_sink()[4 * kvh + tid] * LOG2E; }
    __syncthreads();
    const int g = w >> 1, h = 4 * kvh + g;
    const float sk2 = SK[g];
    for (int a4 = 0; a4 < 4; ++a4) {
        const int a = 4 * (w & 1) + a4;
        const size_t qrow = (size_t)b * SEQ + qb * 128 + 16 * a + li;
        bf16x8 qf[2];
        qf[0] = qn0; qf[1] = qn1;
        { const int an = a4 < 3 ? a4 + 1 : a4; qn0 = *(const bf16x8*)(qbase + (size_t)(16 * an) * 512); qn1 = *(const bf16x8*)(qbase + (size_t)(16 * an) * 512 + 32); }
        const int sb0 = 2 * (a >> 1);
        f32x4 st[10];
#pragma unroll
        for (int i = 0; i < 10; ++i) {
            st[i] = (f32x4){0.f, 0.f, 0.f, 0.f};
#pragma unroll
            for (int ks = 0; ks < 2; ++ks) {
                const bf16x8 kf = *(const LAS bf16x8*)(KS + (16 * (sb0 + i) + li) * 72 + 32 * ks + 8 * gq);
                st[i] = mfma16(kf, qf[ks], st[i]);
            }
        }
        const int iq = 16 * a + li;
        float mx = -INFINITY;
        {
            const int base0 = iq + 128 - 16 * sb0 - 4 * gq;
            const LAS float* bp0 = B2 + g * 128 + base0 - 159;
            const int thr = (qb == 0) ? 128 - (16 * sb0 + 4 * gq) : -100000;
#pragma unroll
            for (int i = 0; i < 10; ++i)
#pragma unroll
                for (int r = 0; r < 4; ++r) {
                    const int c = 16 * i + r;
                    const bool valid = ((unsigned)(base0 - c) < 128u) && (c >= thr);
                    const float val = valid ? st[i][r] + bp0[159 - c] : -INFINITY;
                    st[i][r] = val; mx = fmaxf(mx, val);
                }
        }
        mx = xmax32(xmax16(mx)); mx = fmaxf(mx, sk2);
        float l = 0.f;
#pragma unroll
        for (int i = 0; i < 10; ++i)
#pragma unroll
            for (int r = 0; r < 4; ++r) { const float p = ex2(st[i][r] - mx); st[i][r] = p; l += p; }
        l = xsum32(xsum16(l)); l += ex2(sk2 - mx);
        f32x4 ot[4];
#pragma unroll
        for (int db = 0; db < 4; ++db) ot[db] = (f32x4){0.f, 0.f, 0.f, 0.f};
#pragma unroll
        for (int t = 0; t < 5; ++t) {
            const u32x4 pw = pack8(st[2 * t], st[2 * t + 1]);
            const bf16x8 pf = __builtin_bit_cast(bf16x8, pw);
#pragma unroll
            for (int db = 0; db < 4; ++db) {
                const LAS bf16_t* vp = VT + (16 * db + li) * 260 + 16 * (sb0 + 2 * t) + 4 * gq;
                const u32x2 lo = *(const LAS u32x2*)vp, hi = *(const LAS u32x2*)(vp + 16);
                const u32x4 vw = (u32x4){lo.x, lo.y, hi.x, hi.y};
                ot[db] = mfma16(__builtin_bit_cast(bf16x8, vw), pf, ot[db]);
            }
        }
        const float inv = 1.f / l;
#pragma unroll
        for (int db = 0; db < 4; ++db) *(u32x2*)(MIX + qrow * DM + h * 64 + 16 * db + 4 * gq) = pack4(ot[db] * inv);
    }
    __syncthreads();
}

__device__ __forceinline__ void gmlp_unit(const Args& P, LAS unsigned char* lds, int b, int chunk, int ghalf) {
    const int tid = threadIdx.x, lane = tid & 63, w = __builtin_amdgcn_readfirstlane(tid >> 6), li = lane & 15, gq = lane >> 4;
    unsigned char* ws = P.ws();
    const bf16_t* U = (const bf16_t*)(ws + WS_B + B_U0); const bf16_t* GV = (const bf16_t*)(ws + WS_B + B_GV0);
    const float* LNS = (const float*)(ws + WS_LNS); const bf16_t* WT = (const bf16_t*)(ws + WS_WTRIL);
    bf16_t* MIX = (bf16_t*)(ws + WS_A);
    LAS float* STAT = (LAS float*)lds;
    const int gi = w >> 1, grp = 4 * ghalf + gi;
    LAS bf16_t* Vg = (LAS bf16_t*)(lds + 1024 + gi * 18432);
    const int r0 = b * SEQ + chunk * 128;
    bf16x8 wfa[20];
#pragma unroll
    for (int tb = 0; tb < 8; ++tb)
#pragma unroll
        for (int ks = 0; ks <= (tb >> 1); ++ks) wfa[(tb >> 1) * ((tb >> 1) + 1) + (tb & 1) * ((tb >> 1) + 1) + ks] = *(const bf16x8*)(WT + ((size_t)grp * 128 + 16 * tb + li) * 128 + 32 * ks + 8 * gq);
    u32x4 gwa[8];
#pragma unroll
    for (int i = 0; i < 8; ++i) { const int p = (w & 1) * 512 + lane + 64 * i, s = p >> 3, ch = p & 7; gwa[i] = *(const u32x4*)(GV + (size_t)(r0 + s) * 512 + grp * 64 + ch * 8); }
    if (tid < 128) {
        const float* p = LNS + (size_t)(r0 + tid) * 16;
        float s1 = 0.f, s2 = 0.f;
#pragma unroll
        for (int q = 0; q < 8; ++q) { s1 += p[2 * q]; s2 += p[2 * q + 1]; }
        const float mean = s1 * (1.f / 512.f), var = fmaxf(s2 * (1.f / 512.f) - mean * mean, 0.f);
        STAT[2 * tid] = mean; STAT[2 * tid + 1] = rsqrtf(var + EPS);
    }
    __syncthreads();
    const bool lastc = (chunk == SEQ / 128 - 1);
#pragma unroll
    for (int i = 0; i < 8; ++i) {
        const int p = (w & 1) * 512 + lane + 64 * i, s = p >> 3, ch = p & 7;
        const u32x4 gw = gwa[i];
        const float mean = STAT[2 * s], rstd = STAT[2 * s + 1];
        const f32x4 g0 = *(const f32x4*)(P.gmlp_ln_g() + grp * 64 + ch * 8), g1 = *(const f32x4*)(P.gmlp_ln_g() + grp * 64 + ch * 8 + 4);
        const f32x4 b0 = *(const f32x4*)(P.gmlp_ln_b() + grp * 64 + ch * 8), b1 = *(const f32x4*)(P.gmlp_ln_b() + grp * 64 + ch * 8 + 4);
        f32x4 v0, v1;
        v0[0] = (bflo(gw.x) - mean) * rstd * g0[0] + b0[0]; v0[1] = (bfhi(gw.x) - mean) * rstd * g0[1] + b0[1];
        v0[2] = (bflo(gw.y) - mean) * rstd * g0[2] + b0[2]; v0[3] = (bfhi(gw.y) - mean) * rstd * g0[3] + b0[3];
        v1[0] = (bflo(gw.z) - mean) * rstd * g1[0] + b1[0]; v1[1] = (bfhi(gw.z) - mean) * rstd * g1[1] + b1[1];
        v1[2] = (bflo(gw.w) - mean) * rstd * g1[2] + b1[2]; v1[3] = (bfhi(gw.w) - mean) * rstd * g1[3] + b1[3];
        *(LAS u32x4*)(Vg + s * 72 + ch * 8) = pack8(v0, v1);
        if (lastc) { float* o = P.gvp() + ((size_t)(b * 128 + s) * 512) + grp * 64 + ch * 8; *(f32x4*)o = v0; *(f32x4*)(o + 4) = v1; }
    }
    __syncthreads();
#pragma unroll
    for (int tb = 0; tb < 8; ++tb) {
        f32x4 acc[2] = {(f32x4){0.f, 0.f, 0.f, 0.f}, (f32x4){0.f, 0.f, 0.f, 0.f}};
#pragma unroll
        for (int ks = 0; ks <= (tb >> 1); ++ks) {
            const bf16x8 wf = wfa[(tb >> 1) * ((tb >> 1) + 1) + (tb & 1) * ((tb >> 1) + 1) + ks];
#pragma unroll
            for (int ci = 0; ci < 2; ++ci) {
                const int cbk = 2 * (w & 1) + ci;
                const LAS bf16_t* vp = Vg + (32 * ks + 8 * gq + (li >> 2)) * 72 + 16 * cbk + 4 * (li & 3);
                const v4i16_t lo = vtr4(vp), hi = vtr4(vp + 4 * 72);
                const bf16x8 vf = (bf16x8){lo[0], lo[1], lo[2], lo[3], hi[0], hi[1], hi[2], hi[3]};
                acc[ci] = mfma16(vf, wf, acc[ci]);
            }
        }
        const int t = 16 * tb + li;
        const float bias = P.gmlp_b_s()[grp * 128 + t];
#pragma unroll
        for (int ci = 0; ci < 2; ++ci) {
            const int cbk = 2 * (w & 1) + ci, c = grp * 64 + 16 * cbk + 4 * gq;
            const u32x2 uw = *(const u32x2*)(U + (size_t)(r0 + t) * 512 + c);
            f32x4 o; o[0] = bflo(uw.x) * (acc[ci][0] + bias); o[1] = bfhi(uw.x) * (acc[ci][1] + bias); o[2] = bflo(uw.y) * (acc[ci][2] + bias); o[3] = bfhi(uw.y) * (acc[ci][3] + bias);
            *(u32x2*)(MIX + (size_t)(r0 + t) * DM + 512 + c) = pack4(o);
        }
    }
    __syncthreads();
}

__device__ __forceinline__ void attn_sample_wave(const Args& P, LAS float* scr  , int b, int kvh) {
    const int lane = threadIdx.x & 63;
    unsigned char* ws = P.ws();
    const bf16_t* Q = (const bf16_t*)(ws + WS_B + B_Q0); bf16_t* MIX = (bf16_t*)(ws + WS_A); const float* B2g = (const float*)(ws + WS_BIAS2);
    LAS float* qs = scr; LAS float* ps = scr + 256;
    const size_t row = (size_t)MP + b;
#pragma unroll
    for (int hh = 0; hh < 4; ++hh) qs[hh * 64 + lane] = bf2f(Q[row * 512 + (4 * kvh + hh) * 64 + lane]);
    float sc[2][4];
#pragma unroll
    for (int i = 0; i < 2; ++i) {
        const int a = lane + 64 * i;
        const float* kp = (a < 127) ? P.cache_k() + ((size_t)(b * 128 + a + 1) * 2 + kvh) * 64 : P.nks() + ((size_t)(b * 128 + 127) * 2 + kvh) * 64;
        float* ko = P.nks() + ((size_t)(b * 128 + (a < 127 ? a : 127)) * 2 + kvh) * 64;
        float d0 = 0.f, d1 = 0.f, d2 = 0.f, d3 = 0.f;
#pragma unroll 4
        for (int c = 0; c < 16; ++c) {
            const f32x4 k4 = *(const f32x4*)(kp + 4 * c);
            if (a < 127) *(f32x4*)(ko + 4 * c) = k4;
            const f32x4 q0 = *(const LAS f32x4*)(qs + 4 * c), q1 = *(const LAS f32x4*)(qs + 64 + 4 * c), q2 = *(const LAS f32x4*)(qs + 128 + 4 * c), q3 = *(const LAS f32x4*)(qs + 192 + 4 * c);
            d0 += (q0[0] * k4[0] + q0[1] * k4[1]) + (q0[2] * k4[2] + q0[3] * k4[3]);
            d1 += (q1[0] * k4[0] + q1[1] * k4[1]) + (q1[2] * k4[2] + q1[3] * k4[3]);
            d2 += (q2[0] * k4[0] + q2[1] * k4[1]) + (q2[2] * k4[2] + q2[3] * k4[3]);
            d3 += (q3[0] * k4[0] + q3[1] * k4[1]) + (q3[2] * k4[2] + q3[3] * k4[3]);
        }
        const float* bb = B2g + (4 * kvh) * 128 + (127 - a);
        sc[i][0] = d0 + bb[0]; sc[i][1] = d1 + bb[128]; sc[i][2] = d2 + bb[256]; sc[i][3] = d3 + bb[384];
        asm volatile("" ::: "memory");
    }
    float linv[4];
#pragma unroll
    for (int hh = 0; hh < 4; ++hh) {
        const float sk2 = P.attn_sink()[4 * kvh + hh] * LOG2E;
        const float mx = fmaxf(wmax(fmaxf(sc[0][hh], sc[1][hh])), sk2);
        const float p0 = ex2(sc[0][hh] - mx), p1 = ex2(sc[1][hh] - mx);
        const float l = wsum(p0 + p1) + ex2(sk2 - mx);
        linv[hh] = 1.f / l;
        ps[hh * 128 + lane] = p0; ps[hh * 128 + 64 + lane] = p1;
    }
    float o[4] = {0.f, 0.f, 0.f, 0.f};
#pragma unroll 8
    for (int a = 0; a < 128; ++a) {
        const float vv = (a < 127) ? P.cache_v()[((size_t)(b * 128 + a + 1) * 2 + kvh) * 64 + lane] : P.nvs()[((size_t)(b * 128 + 127) * 2 + kvh) * 64 + lane];
        if (a < 127) P.nvs()[((size_t)(b * 128 + a) * 2 + kvh) * 64 + lane] = vv;
#pragma unroll
        for (int hh = 0; hh < 4; ++hh) o[hh] += ps[hh * 128 + a] * vv;
    }
#pragma unroll
    for (int hh = 0; hh < 4; ++hh) MIX[row * DM + (4 * kvh + hh) * 64 + lane] = f2bf(o[hh] * linv[hh]);
}
__device__ __forceinline__ void attn_sample_block(const Args& P, LAS unsigned char* lds, int b, int kvh) {
    const int tid = threadIdx.x, lane = tid & 63, w = __builtin_amdgcn_readfirstlane(tid >> 6);
    unsigned char* ws = P.ws();
    const bf16_t* Q = (const bf16_t*)(ws + WS_QS) - (size_t)MP * 512; bf16_t* MIX = (bf16_t*)(ws + WS_A); const float* B2g = (const float*)(ws + WS_BIAS2);
    LAS float* qs = (LAS float*)lds;
    LAS float* SC = qs + 256;
    LAS float* OP = SC + 512;
    const size_t row = (size_t)MP + b;
    const int a = 16 * w + (lane >> 2), qd = lane & 3;
    const float* kp = ((a < 127) ? P.cache_k() + ((size_t)(b * 128 + a + 1) * 2 + kvh) * 64 : P.nks() + ((size_t)(b * 128 + 127) * 2 + kvh) * 64) + 16 * qd;
    f32x4 k4[4];
#pragma unroll
    for (int c = 0; c < 4; ++c) k4[c] = *(const f32x4*)(kp + 4 * c);
    float vv[16];
#pragma unroll
    for (int i = 0; i < 16; ++i) {
        const int av = 16 * w + i;
        vv[i] = (av < 127) ? P.cache_v()[((size_t)(b * 128 + av + 1) * 2 + kvh) * 64 + lane] : P.nvs()[((size_t)(b * 128 + 127) * 2 + kvh) * 64 + lane];
    }
    if (tid < 256) qs[tid] = bf2f(Q[row * 512 + (4 * kvh + (tid >> 6)) * 64 + (tid & 63)]);
    __syncthreads();
    {
        if (a < 127) { float* ko = P.nks() + ((size_t)(b * 128 + a) * 2 + kvh) * 64 + 16 * qd;
#pragma unroll
            for (int c = 0; c < 4; ++c) *(f32x4*)(ko + 4 * c) = k4[c]; }
        float dsum[4];
#pragma unroll
        for (int hh = 0; hh < 4; ++hh) {
            float dd = 0.f;
#pragma unroll
            for (int c = 0; c < 4; ++c) { const f32x4 q4 = *(const LAS f32x4*)(qs + hh * 64 + 16 * qd + 4 * c); dd += (q4[0] * k4[c][0] + q4[1] * k4[c][1]) + (q4[2] * k4[c][2] + q4[3] * k4[c][3]); }
            dd += __shfl_xor(dd, 1); dd += __shfl_xor(dd, 2);
            dsum[hh] = dd;
        }
        if (qd == 0) {
#pragma unroll
            for (int hh = 0; hh < 4; ++hh) SC[hh * 128 + a] = dsum[hh] + B2g[(4 * kvh + hh) * 128 + (127 - a)];
        }
    }
    __syncthreads();
    if (w < 4) {
        const float sk2 = P.attn_sink()[4 * kvh + w] * LOG2E;
        const float s0 = SC[w * 128 + lane], s1 = SC[w * 128 + 64 + lane];
        const float mx = fmaxf(wmax(fmaxf(s0, s1)), sk2);
        const float p0 = ex2(s0 - mx), p1 = ex2(s1 - mx);
        const float inv = 1.f / (wsum(p0 + p1) + ex2(sk2 - mx));
        SC[w * 128 + lane] = p0 * inv; SC[w * 128 + 64 + lane] = p1 * inv;
    }
    __syncthreads();
    {
        float o[4] = {0.f, 0.f, 0.f, 0.f};
#pragma unroll
        for (int i = 0; i < 16; ++i) {
            const int a = 16 * w + i;
            if (a < 127) P.nvs()[((size_t)(b * 128 + a) * 2 + kvh) * 64 + lane] = vv[i];
#pragma unroll
            for (int hh = 0; hh < 4; ++hh) o[hh] += SC[hh * 128 + a] * vv[i];
        }
#pragma unroll
        for (int hh = 0; hh < 4; ++hh) OP[(w * 4 + hh) * 64 + lane] = o[hh];
    }
    __syncthreads();
    if (tid < 256) {
        float o = 0.f;
#pragma unroll
        for (int ww = 0; ww < 8; ++ww) o += OP[(ww * 4 + (tid >> 6)) * 64 + (tid & 63)];
        MIX[row * DM + (4 * kvh + (tid >> 6)) * 64 + (tid & 63)] = f2bf(o);
    }
    __syncthreads();
}
__device__ __forceinline__ void gmlp_sample_wave(const Args& P, int b) {
    const int lane = threadIdx.x & 63;
    unsigned char* ws = P.ws();
    const bf16_t* U = (const bf16_t*)(ws + WS_B + B_U0); const bf16_t* GV = (const bf16_t*)(ws + WS_B + B_GV0);
    const float* LNS = (const float*)(ws + WS_LNS); bf16_t* MIX = (bf16_t*)(ws + WS_A);
    const size_t row = (size_t)MP + b;
    float s1 = 0.f, s2 = 0.f;
#pragma unroll
    for (int q = 0; q < 8; ++q) { s1 += LNS[row * 16 + 2 * q]; s2 += LNS[row * 16 + 2 * q + 1]; }
    const float mean = s1 * (1.f / 512.f), rstd = rsqrtf(fmaxf(s2 * (1.f / 512.f) - mean * mean, 0.f) + EPS);
    const int c = lane * 8, grp = c >> 6;
    const u32x4 gw = *(const u32x4*)(GV + row * 512 + c), uw = *(const u32x4*)(U + row * 512 + c);
    const float g8[8] = {bflo(gw.x), bfhi(gw.x), bflo(gw.y), bfhi(gw.y), bflo(gw.z), bfhi(gw.z), bflo(gw.w), bfhi(gw.w)};
    const float u8[8] = {bflo(uw.x), bfhi(uw.x), bflo(uw.y), bfhi(uw.y), bflo(uw.z), bfhi(uw.z), bflo(uw.w), bfhi(uw.w)};
    const float w00 = P.gmlp_w_s()[(size_t)grp * 128 * 128], bs0 = P.gmlp_b_s()[grp * 128];
    f32x4 v0, v1, o0, o1;
#pragma unroll
    for (int e = 0; e < 4; ++e) {
        v0[e] = (g8[e] - mean) * rstd * P.gmlp_ln_g()[c + e] + P.gmlp_ln_b()[c + e];
        v1[e] = (g8[4 + e] - mean) * rstd * P.gmlp_ln_g()[c + 4 + e] + P.gmlp_ln_b()[c + 4 + e];
        o0[e] = u8[e] * (w00 * v0[e] + bs0); o1[e] = u8[4 + e] * (w00 * v1[e] + bs0);
    }
    *(f32x4*)(P.gvs() + (size_t)b * 512 + c) = v0; *(f32x4*)(P.gvs() + (size_t)b * 512 + c + 4) = v1;
    *(u32x4*)(MIX + row * DM + 512 + c) = pack8(o0, o1);
}

__device__ __forceinline__ void hgrn_scan_a(const Args& P, LAS unsigned char* lds, int b, int h, int seg) {
    const int tid = threadIdx.x, lane = tid & 63, w = __builtin_amdgcn_readfirstlane(tid >> 6), li = lane & 15, gq = lane >> 4;
    unsigned char* ws = P.ws();
    const bf16_t* K1 = (const bf16_t*)(ws + WS_B + A_BYTES); const bf16_t* I1 = (const bf16_t*)(ws + WS_B + 2 * A_BYTES); const unsigned short* F1 = (const unsigned short*)(ws + WS_B + 4 * A_BYTES);
    float* SLOC = (float*)(ws + WS_SLOC); float* ATOT = (float*)(ws + WS_ATOT);
    LAS bf16_t* KHT = (LAS bf16_t*)lds; LAS bf16_t* VT = (LAS bf16_t*)(lds + 34816); LAS float* TOT = (LAS float*)(lds + 69632);
    const int dp = lane, rg = w;
    const int unit = (b * 8 + h) * NSEG + seg;
    const size_t rowseg = (size_t)b * SEQ + (size_t)seg * SEGLEN;
    const size_t col2 = (size_t)h * 128 + 2 * dp;
    f32x4 Sacc[8];
#pragma unroll
    for (int db = 0; db < 8; ++db) Sacc[db] = (f32x4){0.f, 0.f, 0.f, 0.f};
    float C0 = 1.f, C1 = 1.f;
    constexpr int NSB = SEGLEN / 128;
    unsigned fr[16], ir[16];
#pragma unroll
    for (int j = 0; j < 16; ++j) { const size_t off = (rowseg + (size_t)(NSB - 1) * 128 + 16 * rg + j) * DM + col2; fr[j] = *(const unsigned*)(F1 + off); ir[j] = *(const unsigned*)(I1 + off); }
    for (int sb = NSB - 1; sb >= 0; --sb) {
        float e0[16], e1[16], k0f[16], k1f[16]; unsigned vv[16];
        { float p0 = 1.f, p1 = 1.f;
#pragma unroll
          for (int j = 15; j >= 0; --j) { const float f0 = h2f((unsigned short)(fr[j] & 0xffffu)), f1 = h2f((unsigned short)(fr[j] >> 16)); e0[j] = p0; e1[j] = p1; p0 *= f0; p1 *= f1; k0f[j] = 1.f - f0; k1f[j] = 1.f - f1; vv[j] = ir[j]; }
          *(LAS f32x2*)(TOT + rg * 128 + 2 * dp) = (f32x2){p0, p1}; }
        { const int nsb = sb > 0 ? sb - 1 : sb;
#pragma unroll
          for (int j = 0; j < 16; ++j) { const size_t off = (rowseg + (size_t)nsb * 128 + 16 * rg + j) * DM + col2; fr[j] = *(const unsigned*)(F1 + off); ir[j] = *(const unsigned*)(I1 + off); } }
        __syncthreads();
        float g0 = C0, g1 = C1, t0 = 1.f, t1 = 1.f;
#pragma unroll
        for (int r2 = 0; r2 < 8; ++r2) { const f32x2 tt = *(const LAS f32x2*)(TOT + r2 * 128 + 2 * dp); t0 *= tt.x; t1 *= tt.y; if (r2 > rg) { g0 *= tt.x; g1 *= tt.y; } }
        {
            unsigned k0w[8], k1w[8], v0w[8], v1w[8];
#pragma unroll
            for (int jj = 0; jj < 8; ++jj) {
                const int ja = 2 * jj, jb = 2 * jj + 1;
                k0w[jj] = cvt_pk_bf16(k0f[ja] * (e0[ja] * g0), k0f[jb] * (e0[jb] * g0));
                k1w[jj] = cvt_pk_bf16(k1f[ja] * (e1[ja] * g1), k1f[jb] * (e1[jb] * g1));
                v0w[jj] = (vv[ja] & 0xffffu) | (vv[jb] << 16);
                v1w[jj] = (vv[ja] >> 16) | (vv[jb] & 0xffff0000u);
            }
            LAS u32x4* kp0 = (LAS u32x4*)(KHT + (2 * dp) * 136 + 16 * rg); LAS u32x4* kp1 = (LAS u32x4*)(KHT + (2 * dp + 1) * 136 + 16 * rg);
            LAS u32x4* vp0 = (LAS u32x4*)(VT + (2 * dp) * 136 + 16 * rg); LAS u32x4* vp1 = (LAS u32x4*)(VT + (2 * dp + 1) * 136 + 16 * rg);
            kp0[0] = (u32x4){k0w[0], k0w[1], k0w[2], k0w[3]}; kp0[1] = (u32x4){k0w[4], k0w[5], k0w[6], k0w[7]};
            kp1[0] = (u32x4){k1w[0], k1w[1], k1w[2], k1w[3]}; kp1[1] = (u32x4){k1w[4], k1w[5], k1w[6], k1w[7]};
            vp0[0] = (u32x4){v0w[0], v0w[1], v0w[2], v0w[3]}; vp0[1] = (u32x4){v0w[4], v0w[5], v0w[6], v0w[7]};
            vp1[0] = (u32x4){v1w[0], v1w[1], v1w[2], v1w[3]}; vp1[1] = (u32x4){v1w[4], v1w[5], v1w[6], v1w[7]};
        }
        C0 *= t0; C1 *= t1;
        __syncthreads();
#pragma unroll
        for (int ks = 0; ks < 4; ++ks) {
            const bf16x8 bb = *(const LAS bf16x8*)(VT + (16 * w + li) * 136 + 32 * ks + 8 * gq);
#pragma unroll
            for (int db = 0; db < 8; ++db) {
                const bf16x8 a = *(const LAS bf16x8*)(KHT + (16 * db + li) * 136 + 32 * ks + 8 * gq);
                Sacc[db] = mfma16(a, bb, Sacc[db]);
            }
        }
        __syncthreads();
    }
    float* sl = SLOC + (size_t)unit * 16384;
#pragma unroll
    for (int db = 0; db < 8; ++db)
#pragma unroll
        for (int r = 0; r < 4; ++r) sl[((w * 8 + db) * 4 + r) * 64 + lane] = Sacc[db][r];
    if (rg == 0) *(f32x2*)(ATOT + (size_t)unit * 128 + 2 * dp) = (f32x2){C0, C1};
}

template <int MODE = 0>
__device__ __forceinline__ void hgrn_scan_b(const Args& P, LAS unsigned char* lds, int b, int h, int seg) {
    const int tid = threadIdx.x, lane = tid & 63, w = __builtin_amdgcn_readfirstlane(tid >> 6), li = lane & 15, gq = lane >> 4;
    unsigned char* ws = P.ws();
    const bf16_t* Q1 = (const bf16_t*)(ws + WS_B); const bf16_t* K1 = (const bf16_t*)(ws + WS_B + A_BYTES); const bf16_t* I1 = (const bf16_t*)(ws + WS_B + 2 * A_BYTES);
    const bf16_t* SG1 = (const bf16_t*)(ws + WS_B + 3 * A_BYTES); const unsigned short* F1 = (const unsigned short*)(ws + WS_B + 4 * A_BYTES);
    bf16_t* MIX = (bf16_t*)(ws + WS_A);
    const float* SLOC = (const float*)(ws + WS_SLOC); const float* ATOT = (const float*)(ws + WS_ATOT);
    LAS bf16_t* QT = (LAS bf16_t*)lds; LAS bf16_t* KT = (LAS bf16_t*)(lds + 8704); LAS bf16_t* KHT = (LAS bf16_t*)(lds + 17408); LAS bf16_t* VT = (LAS bf16_t*)(lds + 27648);
    LAS bf16_t* ATT = (LAS bf16_t*)(lds + 37888); LAS bf16_t* ST = (LAS bf16_t*)(lds + 40448);
    LAS float* AC = (LAS float*)(lds + 75264); LAS float* TOT = (LAS float*)(lds + 75776); LAS float* OT = (LAS float*)(lds + 79872);
    const int dp = lane, rg = w;
    f32x4 Sacc[8];
#pragma unroll
    for (int db = 0; db < 8; ++db) Sacc[db] = (f32x4){0.f, 0.f, 0.f, 0.f};
    if (MODE != 1) {
        f32x4 D[8];
#pragma unroll
        for (int db = 0; db < 8; ++db) D[db] = (f32x4){1.f, 1.f, 1.f, 1.f};
        for (int i = seg - 1; i >= 0; --i) {
            const int ui = (b * 8 + h) * NSEG + i;
            const float* sl = SLOC + (size_t)ui * 16384; const float* at = ATOT + (size_t)ui * 128;
            float nzacc = 0.f;
#pragma unroll
            for (int db = 0; db < 8; ++db) {
                const f32x4 a4 = *(const f32x4*)(at + 16 * db + 4 * gq);
#pragma unroll
                for (int r = 0; r < 4; ++r) Sacc[db][r] += D[db][r] * sl[((w * 8 + db) * 4 + r) * 64 + lane];
                D[db] = D[db] * a4;
                nzacc = fmaxf(nzacc, fmaxf(fmaxf(D[db][0], D[db][1]), fmaxf(D[db][2], D[db][3])));
            }
            if (!__any(nzacc > 0.f)) break;
        }
    }
#pragma unroll
    for (int db = 0; db < 8; ++db) *(LAS u32x2*)(ST + (16 * w + li) * 136 + 16 * db + 4 * gq) = pack4(Sacc[db]);
    TSTAMP_MAX(59);
    const size_t rowseg = (size_t)b * SEQ + (size_t)seg * SEGLEN;
    const size_t col2 = (size_t)h * 128 + 2 * dp;
    constexpr int NCH = (MODE == 2) ? 1 : SEGLEN / CH;
    const int ot = tid >> 4, oe = (tid & 15) * 8;
    const f32x4 wn0 = *(const f32x4*)(P.c_out_norm() + oe), wn1 = *(const f32x4*)(P.c_out_norm() + oe + 4);
    unsigned fr[4], qr[4], ir[4]; u32x4 sgr;
    unsigned fr2[4], qr2[4], ir2[4]; u32x4 sgr2;
#pragma unroll
    for (int j = 0; j < 4; ++j) { const size_t off = (rowseg + 4 * rg + j) * DM + col2; fr[j] = *(const unsigned*)(F1 + off); ir[j] = *(const unsigned*)(I1 + off); qr[j] = *(const unsigned*)(Q1 + off); }
    sgr = *(const u32x4*)(SG1 + (rowseg + ot) * DM + h * 128 + oe);
#pragma unroll
    for (int j = 0; j < 4; ++j) { const size_t off = (rowseg + CH + 4 * rg + j) * DM + col2; fr2[j] = *(const unsigned*)(F1 + off); ir2[j] = *(const unsigned*)(I1 + off); qr2[j] = *(const unsigned*)(Q1 + off); }
    sgr2 = *(const u32x4*)(SG1 + (rowseg + CH + ot) * DM + h * 128 + oe);
    for (int c = 0; c < NCH; ++c) {
        const size_t row0 = rowseg + (size_t)c * CH;
        float a0[4], a1[4], k0f[4], k1f[4]; unsigned qq[4], vv[4];
        { float p0 = 1.f, p1 = 1.f;
#pragma unroll
          for (int j = 0; j < 4; ++j) { const float f0 = h2f((unsigned short)(fr[j] & 0xffffu)), f1 = h2f((unsigned short)(fr[j] >> 16)); p0 *= f0; p1 *= f1; a0[j] = p0; a1[j] = p1; k0f[j] = 1.f - f0; k1f[j] = 1.f - f1; qq[j] = qr[j]; vv[j] = ir[j]; }
          *(LAS f32x2*)(TOT + rg * 128 + 2 * dp) = (f32x2){p0, p1}; }
        const u32x4 sgc = sgr;
        { const size_t nrow = row0 + ((c + 2 < NCH) ? 2 * CH : 0);
#pragma unroll
          for (int j = 0; j < 4; ++j) { fr[j] = fr2[j]; ir[j] = ir2[j]; qr[j] = qr2[j]; }
          sgr = sgr2;
#pragma unroll
          for (int j = 0; j < 4; ++j) { const size_t off = (nrow + 4 * rg + j) * DM + col2; fr2[j] = *(const unsigned*)(F1 + off); ir2[j] = *(const unsigned*)(I1 + off); qr2[j] = *(const unsigned*)(Q1 + off); }
          sgr2 = *(const u32x4*)(SG1 + (nrow + ot) * DM + h * 128 + oe); }
        __syncthreads();
        float g0 = 1.f, g1 = 1.f, t0 = 1.f, t1 = 1.f;
#pragma unroll
        for (int r2 = 0; r2 < 8; ++r2) { const f32x2 tt = *(const LAS f32x2*)(TOT + r2 * 128 + 2 * dp); t0 *= tt.x; t1 *= tt.y; if (r2 < rg) { g0 *= tt.x; g1 *= tt.y; } }
        {
            unsigned kh0[2], kh1[2], v0w[2], v1w[2];
            float kh0f[4], kh1f[4];
#pragma unroll
            for (int j = 0; j < 4; ++j) {
                const float A0 = a0[j] * g0, A1 = a1[j] * g1, r0 = __builtin_amdgcn_rcpf(A0), r1 = __builtin_amdgcn_rcpf(A1);
                const float kt0 = k0f[j] * r0, kt1 = k1f[j] * r1;
                const int t = 4 * rg + j;
                *(LAS unsigned*)(QT + t * 136 + 2 * dp) = cvt_pk_bf16(bflo(qq[j]) * A0, bfhi(qq[j]) * A1);
                *(LAS unsigned*)(KT + t * 136 + 2 * dp) = cvt_pk_bf16(kt0, kt1);
                kh0f[j] = kt0 * t0; kh1f[j] = kt1 * t1;
            }
            kh0[0] = cvt_pk_bf16(kh0f[0], kh0f[1]); kh0[1] = cvt_pk_bf16(kh0f[2], kh0f[3]);
            kh1[0] = cvt_pk_bf16(kh1f[0], kh1f[1]); kh1[1] = cvt_pk_bf16(kh1f[2], kh1f[3]);
            v0w[0] = (vv[0] & 0xffffu) | (vv[1] << 16); v0w[1] = (vv[2] & 0xffffu) | (vv[3] << 16);
            v1w[0] = (vv[0] >> 16) | (vv[1] & 0xffff0000u); v1w[1] = (vv[2] >> 16) | (vv[3] & 0xffff0000u);
            *(LAS u32x2*)(KHT + (2 * dp) * 40 + 4 * rg) = (u32x2){kh0[0], kh0[1]}; *(LAS u32x2*)(KHT + (2 * dp + 1) * 40 + 4 * rg) = (u32x2){kh1[0], kh1[1]};
            *(LAS u32x2*)(VT + (2 * dp) * 40 + 4 * rg) = (u32x2){v0w[0], v0w[1]}; *(LAS u32x2*)(VT + (2 * dp + 1) * 40 + 4 * rg) = (u32x2){v1w[0], v1w[1]};
            if (rg == 0) *(LAS f32x2*)(AC + 2 * dp) = (f32x2){t0, t1};
        }
        __syncthreads();
        f32x4 O[2];
#pragma unroll
        for (int tb = 0; tb < 2; ++tb) {
            O[tb] = (f32x4){0.f, 0.f, 0.f, 0.f};
#pragma unroll
            for (int ks = 0; ks < 4; ++ks) {
                const bf16x8 a = *(const LAS bf16x8*)(QT + (16 * tb + li) * 136 + 32 * ks + 8 * gq);
                const bf16x8 bb = *(const LAS bf16x8*)(ST + (16 * w + li) * 136 + 32 * ks + 8 * gq);
                O[tb] = mfma16(a, bb, O[tb]);
            }
        }
        if (w < 4) {
            const int tb = w >> 1, sb = w & 1;
            f32x4 at = (f32x4){0.f, 0.f, 0.f, 0.f};
            if (!(tb == 0 && sb == 1)) {
#pragma unroll
                for (int ks = 0; ks < 4; ++ks) {
                    const bf16x8 a = *(const LAS bf16x8*)(QT + (16 * tb + li) * 136 + 32 * ks + 8 * gq);
                    const bf16x8 bb = *(const LAS bf16x8*)(KT + (16 * sb + li) * 136 + 32 * ks + 8 * gq);
                    at = mfma16(a, bb, at);
                }
            }
#pragma unroll
            for (int r = 0; r < 4; ++r) {
                const int t = 16 * tb + 4 * gq + r, s = 16 * sb + li;
                ATT[t * 40 + s] = (s <= t) ? f2bf(at[r]) : (bf16_t)0;
            }
        }
#pragma unroll
        for (int db = 0; db < 8; ++db) {
            const bf16x8 a = *(const LAS bf16x8*)(KHT + (16 * db + li) * 40 + 8 * gq);
            const bf16x8 bb = *(const LAS bf16x8*)(VT + (16 * w + li) * 40 + 8 * gq);
            const f32x4 a4 = *(const LAS f32x4*)(AC + 16 * db + 4 * gq);
            Sacc[db] = mfma16(a, bb, Sacc[db] * a4);
            *(LAS u32x2*)(ST + (16 * w + li) * 136 + 16 * db + 4 * gq) = pack4(Sacc[db]);
        }
        __syncthreads();
#pragma unroll
        for (int tb = 0; tb < 2; ++tb) {
            const bf16x8 a = *(const LAS bf16x8*)(ATT + (16 * tb + li) * 40 + 8 * gq);
            const bf16x8 bb = *(const LAS bf16x8*)(VT + (16 * w + li) * 40 + 8 * gq);
            O[tb] = mfma16(a, bb, O[tb]);
#pragma unroll
            for (int r = 0; r < 4; ++r) OT[(16 * tb + 4 * gq + r) * 132 + 16 * w + li] = O[tb][r];
        }
        __syncthreads();
        {
            const f32x4 o0 = *(const LAS f32x4*)(OT + ot * 132 + oe), o1 = *(const LAS f32x4*)(OT + ot * 132 + oe + 4);
            float ss = sumsq4(o0) + sumsq4(o1);
            ss += __shfl_xor(ss, 1); ss += __shfl_xor(ss, 2); ss += __shfl_xor(ss, 4); ss += __shfl_xor(ss, 8);
            const float rinv = rsqrtf(ss * (1.f / 128.f) + EPS);
            const f32x4 s0 = (f32x4){bflo(sgc.x), bfhi(sgc.x), bflo(sgc.y), bfhi(sgc.y)}, s1 = (f32x4){bflo(sgc.z), bfhi(sgc.z), bflo(sgc.w), bfhi(sgc.w)};
            *(u32x4*)(MIX + (row0 + ot) * DM + h * 128 + oe) = pack8(o0 * wn0 * s0 * rinv, o1 * wn1 * s1 * rinv);
        }
    }
    TSTAMP_MAX(60);
    if (seg == NSEG - 1) {
        float* so = P.stp() + (size_t)(b * 8 + h) * 16384;
#pragma unroll
        for (int db = 0; db < 8; ++db)
#pragma unroll
            for (int r = 0; r < 4; ++r) so[(size_t)(16 * db + 4 * gq + r) * 128 + 16 * w + li] = Sacc[db][r];
    }
    __syncthreads();
}

__device__ __forceinline__ void hgrn_sample_units4(const Args& P, LAS unsigned char* lds, int u0, int n) {
    const int tid = threadIdx.x, lane = tid & 63;
    unsigned char* ws = P.ws();
    const bf16_t* Q1 = (const bf16_t*)(ws + WS_B); const bf16_t* I1 = (const bf16_t*)(ws + WS_B + 2 * A_BYTES);
    const bf16_t* SG1 = (const bf16_t*)(ws + WS_B + 3 * A_BYTES); const unsigned short* LF = (const unsigned short*)(ws + WS_B + 4 * A_BYTES);
    bf16_t* MIX = (bf16_t*)(ws + WS_A);
    LAS float* VEC = (LAS float*)lds;
    LAS float* OP = VEC + 4 * 4 * 128;
    LAS float* RS = OP + 4 * 16 * 128;
    __syncthreads();
    {
        const int u = tid >> 7, dd = tid & 127, su = u0 + (u < n ? u : 0), b = su >> 3, h = su & 7;
        const size_t off = ((size_t)MP + b) * DM + h * 128 + dd;
        const float f = h2f(LF[off]);
        VEC[(u * 4 + 0) * 128 + dd] = f; VEC[(u * 4 + 1) * 128 + dd] = 1.f - f; VEC[(u * 4 + 2) * 128 + dd] = bf2f(Q1[off]); VEC[(u * 4 + 3) * 128 + dd] = bf2f(I1[off]);
    }
    const int e4 = tid & 31, dg = tid >> 5;
    f32x4 pre[8];
    { const float* s0 = P.state_hgrn() + (size_t)u0 * 16384;
#pragma unroll
      for (int dd = 0; dd < 8; ++dd) pre[dd] = *(const f32x4*)(s0 + (size_t)(8 * dg + dd) * 128 + 4 * e4); }
    __syncthreads();
#pragma unroll
    for (int u = 0; u < 4; ++u) {
        if (u >= n) break;
        f32x4 cur[8];
#pragma unroll
        for (int dd = 0; dd < 8; ++dd) cur[dd] = pre[dd];
        if (u + 1 < n) { const float* s0 = P.state_hgrn() + (size_t)(u0 + u + 1) * 16384;
#pragma unroll
            for (int dd = 0; dd < 8; ++dd) pre[dd] = *(const f32x4*)(s0 + (size_t)(8 * dg + dd) * 128 + 4 * e4); }
        const LAS float* fv = VEC + (u * 4 + 0) * 128; const LAS float* kv = fv + 128; const LAS float* qv = kv + 128; const LAS float* iv = qv + 128;
        float* so = P.sts() + (size_t)(u0 + u) * 16384;
        const f32x4 i4 = *(const LAS f32x4*)(iv + 4 * e4);
        f32x4 o4 = (f32x4){0.f, 0.f, 0.f, 0.f};
#pragma unroll
        for (int dd = 0; dd < 8; ++dd) {
            const int dq = 8 * dg + dd;
            const f32x4 sn = cur[dd] * fv[dq] + i4 * kv[dq];
            *(f32x4*)(so + (size_t)dq * 128 + 4 * e4) = sn;
            o4 += sn * qv[dq];
        }
        *(LAS f32x4*)(OP + (u * 16 + dg) * 128 + 4 * e4) = o4;
    }
    __syncthreads();
    const int u = tid >> 7, e = tid & 127, su = u0 + (u < n ? u : 0), b = su >> 3, h = su & 7;
    float o = 0.f;
    if (u < n) {
#pragma unroll
        for (int g = 0; g < 16; ++g) o += OP[(u * 16 + g) * 128 + e];
    }
    { const float s = wsum(o * o); if (lane == 0) RS[tid >> 6] = s; }
    __syncthreads();
    if (u < n) {
        const float rinv = rsqrtf((RS[2 * u] + RS[2 * u + 1]) * (1.f / 128.f) + EPS);
        const size_t off = ((size_t)MP + b) * DM + h * 128 + e;
        MIX[off] = f2bf(o * rinv * P.c_out_norm()[e] * bf2f(SG1[off]));
    }
    __syncthreads();
}

__device__ __forceinline__ void hgrn_sample_unit(const Args& P, LAS unsigned char* lds, int b, int h) {
    const int tid = threadIdx.x, lane = tid & 63;
    unsigned char* ws = P.ws();
    const bf16_t* Q1 = (const bf16_t*)(ws + WS_B); const bf16_t* K1 = (const bf16_t*)(ws + WS_B + A_BYTES); const bf16_t* I1 = (const bf16_t*)(ws + WS_B + 2 * A_BYTES);
    const bf16_t* SG1 = (const bf16_t*)(ws + WS_B + 3 * A_BYTES); const unsigned short* LF = (const unsigned short*)(ws + WS_B + 4 * A_BYTES);
    bf16_t* MIX = (bf16_t*)(ws + WS_A);
    LAS float* fv = (LAS float*)(lds + 81920); LAS float* kv = fv + 128; LAS float* qv = kv + 128; LAS float* iv = qv + 128; LAS float* OP = iv + 128; LAS float* RS = OP + 2048;
    const size_t row = (size_t)MP + b;
    if (tid < 128) {
        const size_t off = row * DM + h * 128 + tid;
        fv[tid] = h2f(LF[off]); kv[tid] = 1.f - fv[tid]; qv[tid] = bf2f(Q1[off]); iv[tid] = bf2f(I1[off]);
    }
    __syncthreads();
    const int e4 = tid & 31, dg = tid >> 5;
    const float* s0 = P.state_hgrn() + (size_t)(b * 8 + h) * 16384; float* so = P.sts() + (size_t)(b * 8 + h) * 16384;
    const f32x4 i4 = *(const LAS f32x4*)(iv + 4 * e4);
    f32x4 o4 = (f32x4){0.f, 0.f, 0.f, 0.f};
#pragma unroll
    for (int dd = 0; dd < 8; ++dd) {
        const int dq = 8 * dg + dd;
        const f32x4 sv = *(const f32x4*)(s0 + (size_t)dq * 128 + 4 * e4);
        const f32x4 sn = sv * fv[dq] + i4 * kv[dq];
        *(f32x4*)(so + (size_t)dq * 128 + 4 * e4) = sn;
        o4 += sn * qv[dq];
    }
    *(LAS f32x4*)(OP + dg * 128 + 4 * e4) = o4;
    __syncthreads();
    float o = 0.f;
    if (tid < 128) {
#pragma unroll
        for (int g = 0; g < 16; ++g) o += OP[g * 128 + tid];
        const float s = wsum(o * o);
        if (lane == 0) RS[tid >> 6] = s;
    }
    __syncthreads();
    if (tid < 128) {
        const float rinv = rsqrtf((RS[0] + RS[1]) * (1.f / 128.f) + EPS);
        const size_t off = row * DM + h * 128 + tid;
        MIX[off] = f2bf(o * rinv * P.c_out_norm()[tid] * bf2f(SG1[off]));
    }
    __syncthreads();
}


template <int K, int NB>
__device__ __forceinline__ void thin_unit(LAS unsigned char* lds, const bf16_t* A  , const bf16_t* Bt, int rg, int cg, f32x4 (&out)[NB]) {
    const int tid = threadIdx.x, lane = tid & 63, w = __builtin_amdgcn_readfirstlane(tid >> 6), li = lane & 15, gq = lane >> 4;
    constexpr int KW = K / 8, NKS = KW / 32;
    const bf16_t* ap = A + (size_t)(16 * rg + li) * K + w * KW + 8 * gq;
    const bf16_t* bp = Bt + (size_t)(16 * NB * cg + li) * K + w * KW + 8 * gq;
    f32x4 acc[NB];
#pragma unroll
    for (int nb = 0; nb < NB; ++nb) acc[nb] = (f32x4){0.f, 0.f, 0.f, 0.f};
#pragma unroll
    for (int ks = 0; ks < NKS; ++ks) {
        const bf16x8 af = *(const bf16x8*)(ap + 32 * ks);
#pragma unroll
        for (int nb = 0; nb < NB; ++nb) {
            const bf16x8 bf = *(const bf16x8*)(bp + (size_t)(16 * nb) * K + 32 * ks);
            acc[nb] = mfma16(bf, af, acc[nb]);
        }
    }
    LAS f32x4* PART = (LAS f32x4*)lds;
#pragma unroll
    for (int nb = 0; nb < NB; ++nb) PART[(w * NB + nb) * 64 + lane] = acc[nb];
    __syncthreads();
    if (w == 0) {
#pragma unroll
        for (int nb = 0; nb < NB; ++nb) {
            f32x4 s = PART[nb * 64 + lane];
#pragma unroll
            for (int p = 1; p < 8; ++p) s += PART[(p * NB + nb) * 64 + lane];
            out[nb] = s;
        }
    }
    __syncthreads();
}
template <int K>
__device__ __forceinline__ void thin_unit_pair(LAS unsigned char* lds, const bf16_t* A, const bf16_t* Bt, int rg0, int cg0, int rg1, int cg1, f32x4 (&out)[4]) {
    const int tid = threadIdx.x, lane = tid & 63, w = __builtin_amdgcn_readfirstlane(tid >> 6), li = lane & 15, gq = lane >> 4;
    constexpr int KW = K / 8, NKS = KW / 32;
    const bf16_t* ap0 = A + (size_t)(16 * rg0 + li) * K + w * KW + 8 * gq; const bf16_t* bp0 = Bt + (size_t)(64 * cg0 + li) * K + w * KW + 8 * gq;
    const bf16_t* ap1 = A + (size_t)(16 * rg1 + li) * K + w * KW + 8 * gq; const bf16_t* bp1 = Bt + (size_t)(64 * cg1 + li) * K + w * KW + 8 * gq;
    f32x4 a0[4], a1[4];
#pragma unroll
    for (int nb = 0; nb < 4; ++nb) { a0[nb] = (f32x4){0.f, 0.f, 0.f, 0.f}; a1[nb] = (f32x4){0.f, 0.f, 0.f, 0.f}; }
#pragma unroll
    for (int ks = 0; ks < NKS; ++ks) {
        const bf16x8 af0 = *(const bf16x8*)(ap0 + 32 * ks), af1 = *(const bf16x8*)(ap1 + 32 * ks);
#pragma unroll
        for (int nb = 0; nb < 4; ++nb) {
            a0[nb] = mfma16(*(const bf16x8*)(bp0 + (size_t)(16 * nb) * K + 32 * ks), af0, a0[nb]);
            a1[nb] = mfma16(*(const bf16x8*)(bp1 + (size_t)(16 * nb) * K + 32 * ks), af1, a1[nb]);
        }
    }
    LAS f32x4* PART = (LAS f32x4*)lds;
#pragma unroll
    for (int nb = 0; nb < 4; ++nb) { PART[(w * 4 + nb) * 64 + lane] = a0[nb]; PART[2048 + (w * 4 + nb) * 64 + lane] = a1[nb]; }
    __syncthreads();
    if (w < 2) {
#pragma unroll
        for (int nb = 0; nb < 4; ++nb) {
            f32x4 s = PART[w * 2048 + nb * 64 + lane];
#pragma unroll
            for (int p = 1; p < 8; ++p) s += PART[w * 2048 + (p * 4 + nb) * 64 + lane];
            out[nb] = s;
        }
    }
    __syncthreads();
}
template <int MODE>
__device__ __forceinline__ void thin_epi_res(const f32x4 (&o)[2], int rg, int cg, const float* xin_s, const bf16_t* RB_, bf16_t* OB, float* OF, float* SS) {
    const int lane = threadIdx.x & 63, li = lane & 15, gq = lane >> 4;
    const int row = MP + 16 * rg + li;
    const int c0 = 32 * cg + 8 * gq;
    f32x4 p0, p1;
    if (MODE == 0) { const float* sp = xin_s + (size_t)(16 * rg + li) * DM + c0; p0 = *(const f32x4*)sp; p1 = *(const f32x4*)(sp + 4); }
    else { const u32x4 w = *(const u32x4*)(RB_ + (size_t)row * DM + c0); p0 = (f32x4){bflo(w.x), bfhi(w.x), bflo(w.y), bfhi(w.y)}; p1 = (f32x4){bflo(w.z), bfhi(w.z), bflo(w.w), bfhi(w.w)}; }
    const f32x4 o0 = p0 + o[0], o1 = p1 + o[1];
    if (MODE == 2) { *(f32x4*)(OF + (size_t)row * DM + c0) = o0; *(f32x4*)(OF + (size_t)row * DM + c0 + 4) = o1; }
    else {
        *(u32x4*)(OB + (size_t)row * DM + c0) = pack8(o0, o1);
        float ss = sumsq4(o0) + sumsq4(o1);
        ss = xsum32(xsum16(ss));
        if (gq == 0) SS[(size_t)row * 32 + cg] = ss;
    }
}
__device__ __forceinline__ void thin_epi_inc(const f32x4 (&o)[4], int rg, int cg, const float* SS, const float* LBT, bf16_t* Q1, bf16_t* K1, bf16_t* I1, bf16_t* SG1, unsigned short* LF) {
    const int lane = threadIdx.x & 63, li = lane & 15, gq = lane >> 4;
    const int row = MP + 16 * rg + li;
    const float rinv = row_rinv(SS, row);
#pragma unroll
    for (int h = 0; h < 2; ++h) {
        const int col = 64 * cg + 32 * h + 8 * gq, type = col >> 10, c0 = col & 1023;
        const f32x4 v0 = o[2 * h] * rinv, v1 = o[2 * h + 1] * rinv;
        const size_t off = (size_t)row * DM + c0;
        if (type == 0) *(u32x4*)(Q1 + off) = pack8(v0, v1);
        else if (type == 2) *(u32x4*)(I1 + off) = pack8(v0, v1);
        else if (type == 3) {
            f32x4 s0, s1;
#pragma unroll
            for (int e = 0; e < 4; ++e) { s0[e] = sigm(v0[e]); s1[e] = sigm(v1[e]); }
            *(u32x4*)(SG1 + off) = pack8(s0, s1);
        } else {
            const f32x4 l0 = *(const f32x4*)(LBT + c0), l1 = *(const f32x4*)(LBT + c0 + 4);
            float lf[8];
#pragma unroll
            for (int e = 0; e < 4; ++e) {
                const float f0 = l0[e] + (1.f - l0[e]) * sigm(v0[e]), f1 = l1[e] + (1.f - l1[e]) * sigm(v1[e]);
                lf[e] = f0; lf[4 + e] = f1;
            }
            u32x4 lw;
            lw.x = (unsigned)f2h(lf[0]) | ((unsigned)f2h(lf[1]) << 16); lw.y = (unsigned)f2h(lf[2]) | ((unsigned)f2h(lf[3]) << 16);
            lw.z = (unsigned)f2h(lf[4]) | ((unsigned)f2h(lf[5]) << 16); lw.w = (unsigned)f2h(lf[6]) | ((unsigned)f2h(lf[7]) << 16);
            *(u32x4*)(LF + off) = lw;
        }
    }
}


constexpr int NPH = 12;
__global__ void __launch_bounds__(512, 2) fwd_kernel(Args args) {
    extern __shared__ __attribute__((aligned(16))) unsigned char lds_raw[];
    LAS unsigned char* lds = (LAS unsigned char*)lds_raw;
    const int tid = threadIdx.x, blk = blockIdx.x, G = gridDim.x;
    const int wv = __builtin_amdgcn_readfirstlane(tid >> 6);
    const Args& P = args;
    unsigned char* ws = args.ws_;
    volatile LAS unsigned* MISC = (volatile LAS unsigned*)(lds + MISC_OFF);
    for (int u = tid; u < (LDS_BYTES - RING_BYTES) / 4; u += 512) ((LAS unsigned*)(lds + RING_BYTES))[u] = 0u;
    __syncthreads();
    const int lo = args.ph_lo, hi = args.ph_hi;
    const bool multi = (hi - lo) > 1;
    XcdBarrier bar; bar.bar = (unsigned*)(ws + WS_CTL) + CW_BAR; bar.x = 0; bar.st = nullptr;
    if (multi) bar = xcd_barrier_post((unsigned*)(ws + WS_CTL) + CW_BAR, MISC + 8);
#ifndef PHASE_MASK
#define PHASE_MASK 0xFFF
#endif
#define IN(k) ((((PHASE_MASK) >> (k)) & 1) && lo <= (k) && (k) < hi)
#define SEAM(k) do { if (IN(k) && IN((k) + 1) && rep_ == ((((REPEAT_MASK) >> (k)) & 1) ? 1 : 0)) xcd_barrier(bar); } while (0)
#ifndef REPEAT_MASK
#define REPEAT_MASK 0
#endif
#ifndef FLATSEAM
#define FLATSEAM 1
#endif
#define SEAMF(k, idx) do { if (IN(k) && IN((k) + 1) && rep_ == ((((REPEAT_MASK) >> (k)) & 1) ? 1 : 0)) { \
        if (FLATSEAM && multi && lo == 0) { unsigned* w_ = (unsigned*)(ws + WS_CTL) + 1088 + 136 * (idx); split_arrive(bar, w_, 8); split_wait(bar, w_, 8); } else xcd_barrier(bar); } } while (0)
#define REP(k) for (int rep_ = 0; rep_ < ((((REPEAT_MASK) >> (k)) & 1) ? 2 : 1); ++rep_)
    float* SS = (float*)(ws + WS_SS);
    bf16_t* RA = (bf16_t*)(ws + WS_A); bf16_t* RB = (bf16_t*)(ws + WS_B);

#ifndef SPLIT7
#define SPLIT7 1
#endif
#ifndef P10_ROT
#define P10_ROT (N_GU / BM)
#endif
#ifndef P10_THIN
#define P10_THIN 1
#endif
#ifndef SPLIT5
#define SPLIT5 1
#endif
#ifndef SPLIT8
#define SPLIT8 1
#endif
#ifndef SPLIT4
#define SPLIT4 1
#endif
#ifndef SPLIT2
#define SPLIT2 1
#endif
#ifndef STAGGER
#define STAGGER(b) ((((b) >> 3) & 1) != 0)
#endif
#if defined(TPROBE_A) && defined(TS_PHASE)
#define TSHOOK(n) do { if ((n) == TS_PHASE) g.ts = (unsigned*)(ws + WS_CTL) + 1024 + 48; } while (0)
#else
#define TSHOOK(n) do { } while (0)
#endif
    if (IN(0)) REP(0) { TSTAMP_BEG(0); p0_prologue(P, lds); TSTAMP_END(0); SEAM(0);
#ifdef XBAR_EXTRA
        for (int i_ = 0; i_ < XBAR_EXTRA; ++i_) xcd_barrier(bar);
#endif
    }
    if (IN(1)) REP(1) { TSTAMP_BEG(1);
        Gemm g{(const bf16_t*)P.X(), (const bf16_t*)(ws + WS_W_INAB), MPAD, N_INAB, DM}; StaticOrder S; S.init(MPAD, N_INAB, G, blk);
        TSHOOK(1);
        EpiInAb E{SS, (bf16_t*)(ws + WS_B + B_Q0), (bf16_t*)(ws + WS_B + B_K0), (bf16_t*)(ws + WS_B + B_V0), (bf16_t*)(ws + WS_B + B_U0), (bf16_t*)(ws + WS_B + B_GV0),
                  (float*)(ws + WS_LNS), P.q_norm(), P.k_norm(), P.nkp(), P.nvp(), P.nks(), P.nvs(), (bf16_t*)(ws + WS_QS) - (size_t)MP * 512};
        gemm_phase<EpiInAb, true>(lds, g, S, E);
        wconv_deferred(P, lds, 0, 455 - 256);
        TSTAMP_END(1); SEAMF(1, 0);
    }
    if (IN(2)) REP(2) { TSTAMP_BEG(2);
#ifndef P2_MASK
#define P2_MASK 15
#endif
#ifndef P2_DUP
#define P2_DUP 0
#endif
        if (P2_DUP & 1) { const int b = blk >> 6, qb = (blk >> 1) & 31, kvh = blk & 1; attn_prompt_unit(P, lds, b, qb, kvh); }
        if (P2_DUP & 2) { const int b = blk >> 6, chunk = (blk >> 1) & 31, gh = blk & 1; gmlp_unit(P, lds, b, chunk, gh); }
        const int ux = blk & 7, uj = blk >> 3, ub = ux >> 1, uq = (ux & 1) * 16 + (uj >> 1), uk = uj & 1;
        if (P2_MASK & 1) attn_prompt_unit(P, lds, ub, uq, uk);
        TSTAMP_MAX(62);
        if (P2_MASK & 2) gmlp_unit(P, lds, ub, uq, uk);
        TSTAMP_MAX(63);
        const bool split2 = SPLIT2 && multi && IN(2) && IN(3) && rep_ == ((((REPEAT_MASK) >> 2) & 1) ? 1 : 0);
        if (split2) split_arrive(bar, (unsigned*)(ws + WS_CTL) + 256, 8);
        if (P2_MASK & 4) attn_sample_block(P, lds, blk >> 1, blk & 1);
        if ((P2_MASK & 8) && wv == 1 && blk < 128) gmlp_sample_wave(P, blk);
        __syncthreads();
        TSTAMP_END(2);
        if (split2) split_arrive(bar, (unsigned*)(ws + WS_CTL) + 256 + 136, 8); else SEAM(2);
    }
    if (IN(3)) REP(3) { TSTAMP_BEG(3);
        const bool split2 = SPLIT2 && multi && IN(2) && IN(3) && rep_ == 0;
        const bool late = split2 || STAGGER(blk);
        if (split2) split_wait(bar, (unsigned*)(ws + WS_CTL) + 256, 8);
        if (!late) { f32x4 to[2]; thin_unit<DM, 2>(lds, RA + (size_t)MP * DM, (const bf16_t*)(ws + WS_W_OUTAB), blk >> 5, blk & 31, to);
            if (wv == 0) thin_epi_res<1>(to, blk >> 5, blk & 31, nullptr, (const bf16_t*)P.X(), RB + B_XB / 2, nullptr, SS); }
        TSTAMP_MAX(56);
        { Gemm g{RA, (const bf16_t*)(ws + WS_W_OUTAB), MP, DM, DM}; StaticOrder S; S.init(MP, DM, G, blk);
            TSHOOK(3);
            EpiRes<1> E{nullptr, nullptr, (const bf16_t*)P.X(), RB + B_XB / 2, nullptr, SS};
            gemm_phase<EpiRes<1>, true>(lds, g, S, E); }
        if (split2) split_wait(bar, (unsigned*)(ws + WS_CTL) + 256 + 136, 8);
        if (late) { __syncthreads(); f32x4 to[2]; thin_unit<DM, 2>(lds, RA + (size_t)MP * DM, (const bf16_t*)(ws + WS_W_OUTAB), blk >> 5, blk & 31, to);
            if (wv == 0) thin_epi_res<1>(to, blk >> 5, blk & 31, nullptr, (const bf16_t*)P.X(), RB + B_XB / 2, nullptr, SS); }
        TSTAMP_END(3); SEAMF(3, 1);
    }
    if (IN(4)) REP(4) { TSTAMP_BEG(4);
        const bool split4 = SPLIT4 && multi && IN(4) && IN(5) && rep_ == ((((REPEAT_MASK) >> 4) & 1) ? 1 : 0);
        Gemm g{RB + B_XB / 2, (const bf16_t*)(ws + WS_W_GU0), MPAD, N_GU, DM}; StaticOrder S; S.init(MPAD, N_GU, G, blk); S.rot = split4 ? N_GU / BM : 0;
        EpiGU E{SS, RB + B_HID / 2, split4 ? (unsigned*)(ws + WS_CTL) + CW_SPLIT + 128 : nullptr};
        gemm_phase<EpiGU, true>(lds, g, S, E);
        wconv_deferred(P, lds, 1, 1430 - 5 * 256);
        TSTAMP_END(4);
        if (split4) split_arrive(bar, SPLIT_SET(ws, 4), 8); else SEAM(4);
    }
    if (IN(5)) REP(5) { TSTAMP_BEG(5);
        bf16_t* RX = (bf16_t*)P.X();
        Gemm g{RB + B_HID / 2, (const bf16_t*)(ws + WS_W_DN0), MP, DM, FF}; StaticOrder S; S.init(MP, DM, G, blk);
        const bool split4 = SPLIT4 && multi && IN(4) && IN(5) && rep_ == 0;
        if (split4) {
            if (tid == 0) { unsigned* sg = (unsigned*)(ws + WS_CTL) + CW_SPLIT + 128; XB_SPIN(xb_ld(sg) < (unsigned)(8 * (N_GU / BM)), bar.bar); __builtin_amdgcn_fence(__ATOMIC_ACQUIRE, "agent"); asm volatile("s_waitcnt vmcnt(0)" ::: "memory"); }
            __syncthreads();
        }
        { f32x4 to[2]; thin_unit<FF, 2>(lds, RB + B_HID / 2 + (size_t)MP * FF, (const bf16_t*)(ws + WS_W_DN0), blk >> 5, blk & 31, to);
            if (wv == 0) thin_epi_res<1>(to, blk >> 5, blk & 31, nullptr, RB + B_XB / 2, RX, nullptr, SS); }
        TSTAMP_MAX(57);
        if (split4) split_wait(bar, SPLIT_SET(ws, 4), 8);
        const bool split5 = SPLIT5 && multi && IN(5) && IN(6) && rep_ == ((((REPEAT_MASK) >> 5) & 1) ? 1 : 0);
        if (split5) split_arrive(bar, SPLIT_SET(ws, 0), 8);
        EpiRes<1> E{nullptr, nullptr, RB + B_XB / 2, RX, nullptr, SS};
        gemm_phase<EpiRes<1>, true>(lds, g, S, E);
        TSTAMP_END(5);
        if (split5) split_arrive(bar, SPLIT_SET(ws, 1), 8); else SEAM(5);
    }
    if (IN(6)) REP(6) { TSTAMP_BEG(6);
        const bf16_t* RX = (const bf16_t*)P.X();
        {
            const int tu0 = blk, tu1 = blk + 256;
            f32x4 to[4];
            const int tum = (wv == 1) ? tu1 : tu0;
            const bool split5 = SPLIT5 && multi && IN(5) && IN(6) && rep_ == 0;
            if (split5) split_wait(bar, SPLIT_SET(ws, 0), 8);
            thin_unit_pair<DM>(lds, RX + (size_t)MP * DM, (const bf16_t*)(ws + WS_W_INC), tu0 >> 6, tu0 & 63, tu1 >> 6, tu1 & 63, to);
            if (split5) split_wait(bar, SPLIT_SET(ws, 1), 8);
            if (wv < 2) thin_epi_inc(to, tum >> 6, tum & 63, SS, (const float*)(ws + WS_LBT), RB, RB + A_BYTES / 2, RB + 2 * (A_BYTES / 2), RB + 3 * (A_BYTES / 2), (unsigned short*)(RB + 4 * (A_BYTES / 2)));
        }
        TSTAMP_MAX(58);
        Gemm g{RX, (const bf16_t*)(ws + WS_W_INC), MP, N_INC, DM}; StaticOrder S; S.init(MP, N_INC, G, blk);
        LAS float* LBs = (LAS float*)(lds + RING_BYTES + 4096);
        for (int i = tid; i < 1024; i += 512) LBs[i] = ((const float*)(ws + WS_LBT))[i];
        __syncthreads();
        EpiInC E{SS, (const float*)(ws + WS_LBT), RB, RB + A_BYTES / 2, RB + 2 * (A_BYTES / 2), RB + 3 * (A_BYTES / 2), (unsigned short*)(RB + 4 * (A_BYTES / 2)), LBs};
#ifdef P6_DUP
        gemm_phase<EpiInC, true>(lds, g, S, E);
#endif
        gemm_phase<EpiInC, true>(lds, g, S, E);
        TSTAMP_END(6); SEAMF(6, 2);
    }
    if (IN(7)) REP(7) { TSTAMP_BEG(7);
#ifndef HG_DBG
#define HG_DBG 0
#endif
        if (!(HG_DBG & 2) && blk < 32 * NSEG) { const int bh = blk / NSEG, seg = blk % NSEG; if (seg < NSEG - 1) hgrn_scan_a(P, lds, bh >> 3, bh & 7, seg); else wconv_deferred2(P, lds, 2, bh, 32); }
        TSTAMP_MAX(61); TSTAMP_END(15);
        const bool split7 = IN(7) && IN(8) && rep_ == ((((REPEAT_MASK) >> 7) & 1) ? 1 : 0);
        if (split7 && SPLIT7) split_arrive(bar, (unsigned*)(ws + WS_CTL) + CW_SPLIT + 256);
        if (!(HG_DBG & 4)) hgrn_sample_units4(P, lds, blk * 4, 4);
        TSTAMP_END(7);
        const bool split8 = SPLIT8 && SPLIT7 && split7 && IN(9);
        if (split8) split_arrive(bar, SPLIT_SET(ws, 2), 8);
        if (split7) { if (SPLIT7) split_wait(bar, (unsigned*)(ws + WS_CTL) + CW_SPLIT + 256); else xcd_barrier(bar); }
    }
    if (IN(8)) REP(8) { TSTAMP_BEG(8);
#ifdef HG_PROBE
        if (blk < 32 * NSEG) { const int bh = blk / NSEG, seg = blk % NSEG; hgrn_scan_b<HG_PROBE>(P, lds, bh >> 3, bh & 7, seg); }
#endif
        if (!(HG_DBG & 1)) { if (blk < 32 * NSEG) { const int bh = blk / NSEG, seg = blk % NSEG; hgrn_scan_b<0>(P, lds, bh >> 3, bh & 7, seg); } }
        else { bf16_t* MIXz = (bf16_t*)(ws + WS_A); for (size_t i = (size_t)blk * 512 + tid; i < (size_t)MP * DM / 8; i += (size_t)G * 512) *(u32x4*)(MIXz + i * 8) = (u32x4){0u, 0u, 0u, 0u}; }
        TSTAMP_END(8);
        if (SPLIT8 && SPLIT7 && multi && IN(7) && IN(9) && rep_ == ((((REPEAT_MASK) >> 8) & 1) ? 1 : 0)) split_arrive(bar, SPLIT_SET(ws, 3), 8); else SEAM(8);
    }
    if (IN(9)) REP(9) { TSTAMP_BEG(9);
        const bf16_t* RX = (const bf16_t*)P.X();
        const bool split8 = SPLIT8 && SPLIT7 && multi && IN(7) && IN(8) && rep_ == 0;
        const bool late = !split8 && STAGGER(blk);
        if (split8) split_wait(bar, SPLIT_SET(ws, 2), 8);
        if (!late) { f32x4 to[2]; thin_unit<DM, 2>(lds, RA + (size_t)MP * DM, (const bf16_t*)(ws + WS_W_OUTC), blk >> 5, blk & 31, to);
            if (wv == 0) thin_epi_res<1>(to, blk >> 5, blk & 31, nullptr, RX, RB + B_XB / 2, nullptr, SS); }
        if (split8) split_wait(bar, SPLIT_SET(ws, 3), 8);
        { Gemm g{RA, (const bf16_t*)(ws + WS_W_OUTC), MP, DM, DM}; StaticOrder S; S.init(MP, DM, G, blk);
            TSHOOK(9);
            EpiRes<1> E{nullptr, nullptr, RX, RB + B_XB / 2, nullptr, SS};
            gemm_phase<EpiRes<1>, true>(lds, g, S, E); }
        if (late) { __syncthreads(); f32x4 to[2]; thin_unit<DM, 2>(lds, RA + (size_t)MP * DM, (const bf16_t*)(ws + WS_W_OUTC), blk >> 5, blk & 31, to);
            if (wv == 0) thin_epi_res<1>(to, blk >> 5, blk & 31, nullptr, RX, RB + B_XB / 2, nullptr, SS); }
        TSTAMP_END(9); SEAMF(9, 3);
    }
    if (IN(10)) REP(10) { TSTAMP_BEG(10);
        Gemm g{RB + B_XB / 2, (const bf16_t*)(ws + WS_W_GU1), MPAD, N_GU, DM}; StaticOrder S; S.init(MPAD, N_GU, G, blk); S.rot = P10_ROT;
        unsigned* sg = (unsigned*)(ws + WS_CTL) + CW_SPLIT + 64;
        EpiGU E{SS, RB + B_HID / 2, sg};
        gemm_phase<EpiGU, true>(lds, g, S, E);
        if (P10_THIN && blk >= 1430 - 5 * 256) {
            if (tid == 0) { XB_SPIN(xb_ld(sg) < (unsigned)(8 * (N_GU / BM)), bar.bar); __builtin_amdgcn_fence(__ATOMIC_ACQUIRE, "agent"); asm volatile("s_waitcnt vmcnt(0)" ::: "memory"); }
            __syncthreads();
            for (int u = blk - (1430 - 5 * 256); u < 256; u += G - (1430 - 5 * 256)) {
                f32x4 to[2]; thin_unit<FF, 2>(lds, RB + B_HID / 2 + (size_t)MP * FF, (const bf16_t*)(ws + WS_W_DN1), u >> 5, u & 31, to);
                if (wv == 0) thin_epi_res<2>(to, u >> 5, u & 31, nullptr, RB + B_XB / 2, nullptr, P.X(), nullptr);
            }
        }
        TSTAMP_END(10); SEAMF(10, 4);
    }
    if (IN(11)) REP(11) { TSTAMP_BEG(11);
        if (!P10_THIN) { f32x4 to[2]; thin_unit<FF, 2>(lds, RB + B_HID / 2 + (size_t)MP * FF, (const bf16_t*)(ws + WS_W_DN1), blk >> 5, blk & 31, to);
            if (wv == 0) thin_epi_res<2>(to, blk >> 5, blk & 31, nullptr, RB + B_XB / 2, nullptr, P.X(), nullptr); }
        Gemm g{RB + B_HID / 2, (const bf16_t*)(ws + WS_W_DN1), MP, DM, FF}; StaticOrder S; S.init(MP, DM, G, blk);
        TSHOOK(11);
        EpiRes<2> E{nullptr, nullptr, RB + B_XB / 2, nullptr, P.X(), nullptr};
        gemm_phase<EpiRes<2>, true>(lds, g, S, E);
    }
#ifdef TPROBE_A
    TSTAMP_BEG(12);
    if (blk == 0) {
        __syncthreads();
        unsigned* TS = (unsigned*)(ws + WS_CTL) + TS_WORD0;
        unsigned va = __hip_atomic_load(TS + ((TPROBE_A) & 63), __ATOMIC_RELAXED, __HIP_MEMORY_SCOPE_AGENT), vb = __hip_atomic_load(TS + ((TPROBE_B) & 63), __ATOMIC_RELAXED, __HIP_MEMORY_SCOPE_AGENT);
        if ((TPROBE_A) >= 32 && (TPROBE_A) < 48) va = ~va;
        if ((TPROBE_B) >= 32 && (TPROBE_B) < 48) vb = ~vb;
        const float d = (float)(int)(va - vb) * (TSCALE);
        float* gv = P.gvs();
        for (int i = tid; i < 128 * 512; i += 512) gv[i] += d;
    }
#endif
#undef IN
#undef SEAM
}
}

#ifndef NAIVE_FROM
#define NAIVE_FROM 4
#endif
#ifndef N_LAUNCH_SPLIT
#define N_LAUNCH_SPLIT 0
#endif

#if NAIVE_FROM < 4
static void naive_tail(void* const* d_in, float* out, float* ws, hipStream_t stream, int from) {
    using namespace nv;
    const float* state_hgrn = (const float*)d_in[4];
    const float* norm_mix = (const float*)d_in[5];
    const float* norm_ffn = (const float*)d_in[6];
    const float* w_in_c = (const float*)d_in[17];
    const float* c_lower_bounds = (const float*)d_in[18];
    const float* c_out_norm = (const float*)d_in[19];
    const float* w_out_c = (const float*)d_in[20];
    const float* w_gate = (const float*)d_in[21];
    const float* w_up = (const float*)d_in[22];
    const float* w_down = (const float*)d_in[23];
    float* y_prompt = out;
    float* y_sample = y_prompt + (size_t)NB * SEQ * D;
    float* st_prompt = y_sample + (size_t)DEC * D + 2 * 4 * 128 * 128 + 2 * (size_t)128 * 128 * 128 + 4 * 128 * 512 + 128 * 512;
    float* st_sample = st_prompt + (size_t)4 * 8 * 128 * 128;
    float* H = ws;
    float* Z = H + (size_t)4096 * 1024;
    float* V = Z + (size_t)4096 * 4096;
    float* MIX = V + (size_t)4096 * 512;
    float* G = MIX + (size_t)4096 * 1024;
    float* U = G + (size_t)4096 * 2816;
    (void)hipFuncSetAttribute((const void*)k_hgrn_scan, hipFuncAttributeMaxDynamicSharedMemorySize, (128 * 128 + 256) * 4);
    for (int grp = 0; grp < 5; ++grp) {
        const bool smp = (grp == 4);
        const int R = smp ? DEC : SEQ;
        float* x = smp ? y_sample : y_prompt + (size_t)grp * SEQ * D;
        const int rw = (R + 3) / 4;
        for (int l = 0; l < 2; ++l) {
            const int stage_mix = 2 * l, stage_ffn = 2 * l + 1;
            if (stage_mix >= from && l == 1) {
                k_rmsnorm<<<rw, 256, 0, stream>>>(x, norm_mix + l * D, H, R);
                k_gemm<0><<<dim3(C_IN / 64, R / 64), 256, 0, stream>>>(H, D, w_in_c, C_IN, Z, C_IN, D);
                float* O = H;
                if (!smp) {
                    k_hgrn_scan<<<8, 128, (128 * 128 + 256) * 4, stream>>>(Z, c_lower_bounds, nullptr, O, st_prompt + (size_t)grp * 8 * 128 * 128, R);
                } else {
                    for (int b = 0; b < DEC; ++b)
                        k_hgrn_scan<<<8, 128, (128 * 128 + 256) * 4, stream>>>(Z + (size_t)b * C_IN, c_lower_bounds, state_hgrn + (size_t)b * 8 * 128 * 128, O + (size_t)b * D, st_sample + (size_t)b * 8 * 128 * 128, 1);
                }
                k_hgrn_post<<<(R * 8 + 3) / 4, 256, 0, stream>>>(O, Z, c_out_norm, MIX, R);
                k_gemm<1><<<dim3(D / 64, R / 64), 256, 0, stream>>>(MIX, D, w_out_c, D, x, D, D);
            }
            if (stage_ffn >= from) {
                k_rmsnorm<<<rw, 256, 0, stream>>>(x, norm_ffn + l * D, H, R);
                k_gemm<0><<<dim3(FF / 64, R / 64), 256, 0, stream>>>(H, D, w_gate + (size_t)l * D * FF, FF, G, FF, D);
                k_gemm<0><<<dim3(FF / 64, R / 64), 256, 0, stream>>>(H, D, w_up + (size_t)l * D * FF, FF, U, FF, D);
                k_swiglu<<<(int)(((size_t)R * FF + 255) / 256), 256, 0, stream>>>(G, U, G, (size_t)R * FF);
                k_gemm<1><<<dim3(D / 64, R / 64), 256, 0, stream>>>(G, FF, w_down + (size_t)l * FF * D, D, x, D, FF);
            }
        }
    }
}

#endif

extern "C" void kernel_launch(void* const* d_in, const int* in_sizes, int n_in, void* d_out, int out_size, void* d_ws, size_t ws_size, hipStream_t stream) {
    using namespace fk;
    static int ready = 0;
    if (ready == 0) {
        ready = -1;
        if (n_in != 24 || ws_size < WS_END) { fprintf(stderr, "kernel_launch: unexpected n_in %d / ws_size %zu (need %zu)\n", n_in, ws_size, (size_t)WS_END); return; }
        if (hipFuncSetAttribute((const void*)fwd_kernel, hipFuncAttributeMaxDynamicSharedMemorySize, LDS_BYTES) != hipSuccess) { fprintf(stderr, "kernel_launch: hipFuncSetAttribute failed\n"); return; }
        int dev = 0, cus = 0, per_cu = 0;
        (void)hipGetDevice(&dev); (void)hipDeviceGetAttribute(&cus, hipDeviceAttributeMultiprocessorCount, dev);
        (void)hipOccupancyMaxActiveBlocksPerMultiprocessor(&per_cu, (const void*)fwd_kernel, 512, LDS_BYTES);
        if (cus != 256 || per_cu < 1) { fprintf(stderr, "kernel_launch: needs 256 CUs with >= 1 resident block each (cus %d, per_cu %d)\n", cus, per_cu); (void)hipGetLastError(); return; }
        ready = 1;
    }
    if (ready < 0) return;
    (void)hipMemsetAsync((char*)d_ws + WS_CTL, 0, CTL_ZERO_BYTES, stream);
    Args a{};
    for (int i = 0; i < 24; ++i) a.in[i] = (const float*)d_in[i];
    a.out = (float*)d_out; a.ws_ = (unsigned char*)d_ws;
    const int last = (NAIVE_FROM >= 4) ? NPH : (NAIVE_FROM == 3 ? 10 : (NAIVE_FROM == 2 ? 6 : 4));
#if N_LAUNCH_SPLIT
    for (int p = 0; p < last; ++p) { a.ph_lo = p; a.ph_hi = p + 1; hipLaunchKernelGGL(fwd_kernel, dim3(256), dim3(512), LDS_BYTES, stream, a); }
#else
#ifdef PREFIX_PROBE
    a.ph_lo = 0; a.ph_hi = PREFIX_PROBE;
    hipLaunchKernelGGL(fwd_kernel, dim3(256), dim3(512), LDS_BYTES, stream, a);
    (void)hipMemsetAsync((char*)d_ws + WS_CTL, 0, CTL_BYTES, stream);
#endif
    a.ph_lo = 0; a.ph_hi = last;
    hipLaunchKernelGGL(fwd_kernel, dim3(256), dim3(512), LDS_BYTES, stream, a);
#endif
#if NAIVE_FROM < 4
    naive_tail(d_in, (float*)d_out, (float*)d_ws, stream, NAIVE_FROM);
#endif
}
```
